# Optimizing an MI355X kernel written in HIP

```python
import jax
import jax.numpy as jnp
from jax import lax
import numpy as np

D_MODEL = 1024
BATCH = 16
SEQ = 4096
DEPTH = 1

N_MEM = 256
EPS = 1e-6
D_FF = 2816
HG_HEADS = 4
HG_DK = 128
HG_DV = 128
HG_CHUNK = 64
HG_K = HG_HEADS * HG_DK
HG_V = HG_HEADS * HG_DV
HG_COLS = 2 * HG_K + 2 * HG_V
DIL_GROUPS = ((128, 1), (512, 4), (2048, 16))
DIL_HEADS = 4
DIL_DH = 128
DIL_W = DIL_HEADS * DIL_DH
DIL_COLS = len(DIL_GROUPS) * 3 * DIL_W
ALIBI_HEADS = len(DIL_GROUPS) * DIL_HEADS
MEM_HEADS = 4
MEM_DH = 128
MEM_W = MEM_HEADS * MEM_DH
N_BRANCH = 3
GATE_COLS = N_BRANCH * D_MODEL
SPLITS = (HG_K, 2 * HG_K, 2 * HG_K + HG_V, HG_COLS, HG_COLS + DIL_COLS, HG_COLS + DIL_COLS + MEM_W)
D_IN = HG_COLS + DIL_COLS + MEM_W + GATE_COLS

kernel_name = 'hybrid_hgrn2_dilated_alibi_macaron'


def rmsnorm(x, w):
    xf = x.astype(jnp.float32)
    y = xf * lax.rsqrt(jnp.mean(xf * xf, axis=-1, keepdims=True) + EPS)
    return (y * w.astype(jnp.float32)).astype(x.dtype)


def swiglu(x, w_gu, w_down):
    g, u = jnp.split(x @ w_gu, 2, axis=-1)
    return (jax.nn.silu(g) * u) @ w_down


def alibi_slopes():
    return 2.0 ** (-8.0 * jnp.arange(1, ALIBI_HEADS + 1, dtype=jnp.float32) / ALIBI_HEADS)


def hgrn2(q_raw, f_raw, i_raw, lb):
    B, S = q_raw.shape[:2]
    C = HG_CHUNK
    N = S // C
    f32 = jnp.float32
    q = jax.nn.silu(q_raw.astype(f32)).reshape(B, N, C, HG_HEADS, HG_DK)
    lbh = lb.reshape(HG_HEADS, HG_DK)
    f = lbh + (1.0 - lbh) * jax.nn.sigmoid(f_raw.astype(f32).reshape(B, N, C, HG_HEADS, HG_DK))
    k = 1.0 - f
    v = i_raw.astype(f32).reshape(B, N, C, HG_HEADS, HG_DV)
    b = jnp.cumsum(jnp.log(f), axis=2)
    ref = b[:, :, C // 2 - 1:C // 2]
    scores = jnp.einsum('bnchk,bnshk->bnhcs', q * jnp.exp(b - ref), k * jnp.exp(ref - b))
    causal = jnp.tril(jnp.ones((C, C), dtype=bool))
    scores = jnp.where(causal, scores, 0.0)
    o_intra = jnp.einsum('bnhcs,bnshv->bnchv', scores, v)
    b_last = b[:, :, -1:]
    kv = jnp.einsum('bnshk,bnshv->nbhkv', k * jnp.exp(b_last - b), v)
    decay = jnp.moveaxis(jnp.exp(b_last[:, :, 0]), 1, 0)

    def step(state, inp):
        kv_n, dec_n = inp
        return dec_n[..., None] * state + kv_n, state

    s0 = jnp.zeros((B, HG_HEADS, HG_DK, HG_DV), f32)
    _, s_prev = lax.scan(step, s0, (kv, decay))
    o_inter = jnp.einsum('bnchk,nbhkv->bnchv', q * jnp.exp(b), s_prev)
    return (o_intra + o_inter).reshape(B, S, HG_HEADS, HG_DV)


def dilated_group(q, k, v, window, dil, slopes):
    B, S, H, dh = q.shape
    nk = window // dil
    span = nk * dil
    Sp = -(-S // span) * span
    L = Sp // dil
    nb = L // nk

    def to_sub(t):
        t = jnp.pad(t, ((0, 0), (0, Sp - S), (0, 0), (0, 0)))
        return t.reshape(B, L, dil, H, dh).transpose(0, 2, 1, 3, 4).reshape(B * dil, nb, nk, H, dh)

    qs, ks, vs = to_sub(q), to_sub(k), to_sub(v)
    kb = jnp.concatenate([jnp.pad(ks, ((0, 0), (1, 0), (0, 0), (0, 0), (0, 0)))[:, :-1], ks], axis=2)
    vb = jnp.concatenate([jnp.pad(vs, ((0, 0), (1, 0), (0, 0), (0, 0), (0, 0)))[:, :-1], vs], axis=2)
    s = jnp.einsum('znqhd,znkhd->znhqk', qs, kb).astype(jnp.float32) * (dh ** -0.5)
    qi = jnp.arange(nk)[:, None]
    kj = jnp.arange(2 * nk)[None, :]
    delta = nk + qi - kj
    blk = jnp.arange(nb)[:, None, None]
    valid = (delta >= 0) & (delta <= nk) & ((blk > 0) | (kj >= nk))
    s = s - slopes[:, None, None] * (delta * dil).astype(jnp.float32)
    s = jnp.where(valid[:, None], s, -jnp.inf)
    m = jnp.max(s, axis=-1)
    p = jnp.exp(s - m[..., None])
    l = jnp.sum(p, axis=-1)
    o = jnp.einsum('znhqk,znkhd->znqhd', p.astype(vb.dtype), vb).astype(jnp.float32)
    o = o.reshape(B, dil, L, H, dh).transpose(0, 2, 1, 3, 4).reshape(B, Sp, H, dh)[:, :S]

    def stat_back(t):
        return t.transpose(0, 1, 3, 2).reshape(B, dil, L, H).transpose(0, 2, 1, 3).reshape(B, Sp, H)[:, :S]

    return o, stat_back(m), stat_back(l)


def dilated_attention(dil_cols):
    B, S = dil_cols.shape[:2]
    qkv = dil_cols.reshape(B, S, len(DIL_GROUPS), 3, DIL_HEADS, DIL_DH)
    slopes = alibi_slopes()
    outs, maxs, sums = [], [], []
    for g, (window, dil) in enumerate(DIL_GROUPS):
        o, m, l = dilated_group(qkv[:, :, g, 0], qkv[:, :, g, 1], qkv[:, :, g, 2], window, dil,
                                slopes[g * DIL_HEADS:(g + 1) * DIL_HEADS])
        outs.append(o)
        maxs.append(m)
        sums.append(l)
    m_all = jnp.stack(maxs)
    w = jnp.exp(m_all - jnp.max(m_all, axis=0))
    num = jnp.sum(w[..., None] * jnp.stack(outs), axis=0)
    den = jnp.sum(w * jnp.stack(sums), axis=0)
    return (num / den[..., None]).reshape(B, S, DIL_W).astype(dil_cols.dtype)


def memory_attention(mq, mem, mem_norm_w, w_mem_kv):
    B, S = mq.shape[:2]
    mk, mv = jnp.split(rmsnorm(mem, mem_norm_w) @ w_mem_kv, 2, axis=-1)
    mq = mq.reshape(B, S, MEM_HEADS, MEM_DH)
    mk = mk.reshape(B, N_MEM, MEM_HEADS, MEM_DH)
    mv = mv.reshape(B, N_MEM, MEM_HEADS, MEM_DH)
    s = jnp.einsum('bshd,bmhd->bhsm', mq, mk).astype(jnp.float32) * (MEM_DH ** -0.5)
    p = jax.nn.softmax(s, axis=-1).astype(mv.dtype)
    return jnp.einsum('bhsm,bmhd->bshd', p, mv).reshape(B, S, MEM_W)


def token_mixing(u, mem, w_in, b_gate, lb, hg_norm_w, mem_norm_w, w_mem_kv, w_br_hg, w_br_dil, w_br_mem, w_out):
    B, S, D = u.shape
    proj = u @ w_in
    hq, hf, hi, hog, dcols, mq, gl = jnp.split(proj, SPLITS, axis=-1)
    o_hg = rmsnorm(hgrn2(hq, hf, hi, lb), hg_norm_w)
    o_hg = o_hg * jax.nn.sigmoid(hog.astype(jnp.float32)).reshape(B, S, HG_HEADS, HG_DV)
    y_hg = o_hg.reshape(B, S, HG_V).astype(u.dtype)
    y_dil = dilated_attention(dcols)
    y_mem = memory_attention(mq, mem, mem_norm_w, w_mem_kv)
    gates = jax.nn.sigmoid((gl + b_gate).astype(jnp.float32)).astype(u.dtype).reshape(B, S, N_BRANCH, D)
    y = (gates[:, :, 0] * (y_hg @ w_br_hg)
         + gates[:, :, 1] * (y_dil @ w_br_dil)
         + gates[:, :, 2] * (y_mem @ w_br_mem))
    return y @ w_out


def setup_inputs(seed: int = 0) -> dict:
    key = jax.random.key(seed)
    ks = jax.random.split(key, 22)
    f32 = jnp.float32

    def w(k, shape, fan_in):
        return jax.random.normal(k, shape, f32) * (fan_in ** -0.5)

    def gain(k, n):
        return 1.0 + 0.05 * jax.random.normal(k, (DEPTH, n), f32)

    return {
        'x': jax.random.normal(ks[0], (BATCH, SEQ, D_MODEL), f32),
        'mem': jax.random.normal(ks[1], (BATCH, N_MEM, D_MODEL), f32),
        'ffn1_pre_w': gain(ks[2], D_MODEL),
        'ffn1_w_gu': w(ks[3], (DEPTH, D_MODEL, 2 * D_FF), D_MODEL),
        'ffn1_w_down': w(ks[4], (DEPTH, D_FF, D_MODEL), D_FF),
        'ffn1_post_w': gain(ks[5], D_MODEL),
        'mix_pre_w': gain(ks[6], D_MODEL),
        'w_in': w(ks[7], (DEPTH, D_MODEL, D_IN), D_MODEL),
        'b_gate': 0.01 * jax.random.normal(ks[8], (DEPTH, GATE_COLS), f32),
        'hg_lb_logits': 0.1 * jax.random.normal(ks[9], (DEPTH + 1, HG_K), f32),
        'hg_norm_w': gain(ks[10], HG_DV),
        'mem_norm_w': gain(ks[11], D_MODEL),
        'w_mem_kv': w(ks[12], (DEPTH, D_MODEL, 2 * MEM_W), D_MODEL),
        'w_br_hg': w(ks[13], (DEPTH, HG_V, D_MODEL), HG_V),
        'w_br_dil': w(ks[14], (DEPTH, DIL_W, D_MODEL), DIL_W),
        'w_br_mem': w(ks[15], (DEPTH, MEM_W, D_MODEL), MEM_W),
        'w_out': w(ks[16], (DEPTH, D_MODEL, D_MODEL), D_MODEL),
        'mix_post_w': gain(ks[17], D_MODEL),
        'ffn2_pre_w': gain(ks[18], D_MODEL),
        'ffn2_w_gu': w(ks[19], (DEPTH, D_MODEL, 2 * D_FF), D_MODEL),
        'ffn2_w_down': w(ks[20], (DEPTH, D_FF, D_MODEL), D_FF),
        'ffn2_post_w': gain(ks[21], D_MODEL),
    }


def reference(x, mem, ffn1_pre_w, ffn1_w_gu, ffn1_w_down, ffn1_post_w, mix_pre_w, w_in, b_gate,
              hg_lb_logits, hg_norm_w, mem_norm_w, w_mem_kv, w_br_hg, w_br_dil, w_br_mem, w_out,
              mix_post_w, ffn2_pre_w, ffn2_w_gu, ffn2_w_down, ffn2_post_w):
    lb_all = jnp.cumsum(jax.nn.softmax(hg_lb_logits.astype(jnp.float32), axis=0), axis=0)
    h = x
    for l in range(DEPTH):
        h = h + 0.5 * rmsnorm(swiglu(rmsnorm(h, ffn1_pre_w[l]), ffn1_w_gu[l], ffn1_w_down[l]), ffn1_post_w[l])
        u = rmsnorm(h, mix_pre_w[l])
        y = token_mixing(u, mem, w_in[l], b_gate[l], lb_all[l], hg_norm_w[l], mem_norm_w[l], w_mem_kv[l],
                         w_br_hg[l], w_br_dil[l], w_br_mem[l], w_out[l])
        h = h + rmsnorm(y, mix_post_w[l])
        h = h + 0.5 * rmsnorm(swiglu(rmsnorm(h, ffn2_pre_w[l]), ffn2_w_gu[l], ffn2_w_down[l]), ffn2_post_w[l])
    return h
```

```cpp
#include <hip/hip_runtime.h>
#include <hip/hip_cooperative_groups.h>
#include <cstdio>
#include <cstdint>
namespace cg = cooperative_groups;

#ifndef MK_MULTI
#define MK_MULTI 0
#endif

#define LAS __attribute__((address_space(3)))
typedef unsigned short bf16_t;
typedef short bf16x8 __attribute__((ext_vector_type(8)));
typedef float f32x4 __attribute__((ext_vector_type(4)));
typedef float f32x16 __attribute__((ext_vector_type(16)));
typedef unsigned u32x4 __attribute__((ext_vector_type(4)));
typedef unsigned u32x2 __attribute__((ext_vector_type(2)));

constexpr int T = 65536, TH = 32768, SEQ = 4096, D = 1024, DFF = 2816, DIN = 10240, PITCH = 10240, NMEMROWS = 4096;
constexpr int C_HQ = 0, C_HF = 512, C_HI = 1024, C_HOG = 1536, C_DIL = 2048, C_MQ = 6656, C_GATE = 7168, C_YM = 4096, C_YMIX = 5632;
constexpr float EPS = 1e-6f;
constexpr size_t MiB = 1u << 20, KiB = 1u << 10;
constexpr size_t WS_CTR = 0, WS_TBL = 2 * KiB  , WS_CNT = 4 * KiB  , WS_SS1 = 64 * KiB, WS_SS2 = 320 * KiB, WS_SS3 = 576 * KiB, WS_RSTDM = 832 * KiB;
constexpr size_t WS_STATS = 1 * MiB, WS_XBAR = 4 * MiB  ;
constexpr size_t WS_WGU1 = 5 * MiB, WS_WD1 = 16 * MiB, WS_WIN = WS_WD1 + 5632 * KiB, WS_WMKV = WS_WIN + 20 * MiB, WS_WBR = WS_WMKV + 2 * MiB,
                 WS_WOUT = WS_WBR + 3 * MiB, WS_WGU2 = WS_WOUT + 2 * MiB, WS_WD2 = WS_WGU2 + 11 * MiB;
constexpr size_t WS_MEMB = 65 * MiB, WS_MKV = 73 * MiB, WS_AB = 81 * MiB, WS_R = 209 * MiB, WS_Y1 = WS_R + 352 * MiB, WS_HGKT = WS_R + 640 * MiB, WS_HGVT = WS_HGKT + 32 * MiB, WS_HGSC = WS_HGVT + 32 * MiB, WS_HGD = WS_HGSC + 16 * MiB, WS_END = WS_HGD + 1 * MiB;
static_assert(WS_WD2 + 5632 * KiB <= WS_MEMB, "weights");
constexpr int LDS_BYTES = 140 * 1024, MISC_OFF = 139264;
constexpr int NPH = 17;

__device__ __forceinline__ unsigned f2bf(float f);
typedef float f32x2_t __attribute__((ext_vector_type(2)));
typedef __bf16 bf16x2_t __attribute__((ext_vector_type(2)));
__device__ __forceinline__ unsigned pk2(float lo, float hi) { const f32x2_t v = {lo, hi}; return __builtin_bit_cast(unsigned, __builtin_convertvector(v, bf16x2_t)); }
__device__ __forceinline__ float bflo(unsigned w) { return __builtin_bit_cast(float, w << 16); }
__device__ __forceinline__ float bfhi(unsigned w) { return __builtin_bit_cast(float, w & 0xffff0000u); }
__device__ __forceinline__ float bf2f(bf16_t b) { return __builtin_bit_cast(float, ((unsigned)b) << 16); }
__device__ __forceinline__ float sigmoidf_(float x) { return __builtin_amdgcn_rcpf(1.0f + __expf(-x)); }
__device__ __forceinline__ const float* uptr(const float* p) {
    const unsigned long long v = (unsigned long long)p; const unsigned lo = __builtin_amdgcn_readfirstlane((unsigned)v), hi = __builtin_amdgcn_readfirstlane((unsigned)(v >> 32));
    return (const float*)(__attribute__((address_space(1))) const float*)(((unsigned long long)hi << 32) | lo); }
__device__ __forceinline__ int fresh_lane() { int z = 0; asm volatile("" : "+v"(z)); return (int)__builtin_amdgcn_mbcnt_hi(~0u, __builtin_amdgcn_mbcnt_lo(~0u, (unsigned)z)); }
__device__ __forceinline__ float shfl_xor_f(float v, int o) { const int l = fresh_lane(); return __builtin_bit_cast(float, __builtin_amdgcn_ds_bpermute((l ^ o) << 2, __builtin_bit_cast(int, v))); }
__device__ __forceinline__ float wave_sum(float v) {
    const int l = fresh_lane();
#pragma unroll
    for (int o = 1; o < 64; o <<= 1) v += __builtin_bit_cast(float, __builtin_amdgcn_ds_bpermute((l ^ o) << 2, __builtin_bit_cast(int, v)));
    return v;
}
__device__ __forceinline__ unsigned cvt_pk_bf16(float lo, float hi) { return pk2(lo, hi); }
__device__ __forceinline__ unsigned f2bf(float f) { return pk2(f, 0.f) & 0xffffu; }

namespace pg8 {
constexpr int BM = 256, BK = 64, HALF = 128, HTB = HALF * BK * 2, NXCD = 8, WGM = 8;
__device__ __forceinline__ int lds_byte(int r, int c) { const int st = (r >> 4) * 2 + (c >> 5), rr = r & 15, cc = c & 31, ob = rr * 64 + cc * 2; return st * 1024 + (ob ^ (((ob >> 9) & 1) << 5)); }
__device__ __forceinline__ void stage_rc(int b, int& R, int& C) { const int st = b / 1024, sb = b % 1024, swz = sb ^ (((sb >> 9) & 1) << 5); R = (st >> 1) * 16 + swz / 64; C = (st & 1) * 32 + (swz % 64) / 2; }
__device__ __forceinline__ int perm32(int rho) { const int n = rho >> 4, i = rho & 15; return 8 * (i >> 2) + 4 * n + (i & 3); }

struct Unit { int pm, pn, seg; };
struct Gemm { const bf16_t* A0; const bf16_t* A1; const bf16_t* A2; const bf16_t* B0; const bf16_t* B1; const bf16_t* B2; int lda, ldb, K; };

template <int NSEG> struct OrderT {
    int nM, nN, nwg, G, c;
    __device__ void init(int M, int N, int G_, int c_) { nM = M / BM; nN = N / BM; nwg = nM * nN; G = G_; c = c_; }
    __device__ bool next(int i, Unit& u) const {
        const int rnd = i / NSEG; u.seg = i - rnd * NSEG;
        const long L = (long)rnd * G + c; if (L >= nwg) return false;
        int wgid = (int)L; { const int q = nwg / NXCD, r = nwg % NXCD, xcd = wgid % NXCD, off = wgid / NXCD; wgid = (xcd < r ? xcd * (q + 1) : r * (q + 1) + (xcd - r) * q) + off; }
        const int nig = WGM * nN, gid = wgid / nig, fm = gid * WGM, gsz = (nM - fm) < WGM ? (nM - fm) : WGM;
        u.pm = fm + ((wgid % nig) % gsz); u.pn = (wgid % nig) / gsz; return true;
    }
};

#define ZERO_ACC() do { _Pragma("unroll") for (int a_ = 0; a_ < 2; ++a_) _Pragma("unroll") for (int b_ = 0; b_ < 2; ++b_) _Pragma("unroll") for (int m_ = 0; m_ < 4; ++m_) _Pragma("unroll") for (int n_ = 0; n_ < 2; ++n_) acc[a_][b_][m_][n_] = (f32x4){0.f, 0.f, 0.f, 0.f}; } while (0)

struct EpiSwiGLU {
    bf16_t* H; const float* rstd;
    __device__ __forceinline__ void operator()(f32x4 (&acc)[2][2][4][2], const Unit& u, int wr, int wc, int fr, int fq, LAS unsigned char* lds, int wid, int lane) const {
        const int row0 = u.pm * BM + wr * 64 + fr, col0 = u.pn * 128 + wc * 32 + 8 * fq;
        float ssv[2][4];
#pragma unroll
        for (int ai = 0; ai < 2; ++ai)
#pragma unroll
            for (int m = 0; m < 4; ++m) ssv[ai][m] = rstd[row0 + ai * HALF + m * 16];
#pragma unroll
        for (int ai = 0; ai < 2; ++ai)
#pragma unroll
            for (int m = 0; m < 4; ++m) {
                const int row = row0 + ai * HALF + m * 16; const float rs = __builtin_amdgcn_rsqf(ssv[ai][m] * (1.0f / D) + EPS);
                float hv[8];
#pragma unroll
                for (int n = 0; n < 2; ++n)
#pragma unroll
                    for (int j = 0; j < 4; ++j) { const float g = acc[ai][0][m][n][j] * rs, uu = acc[ai][1][m][n][j] * rs; hv[n * 4 + j] = g * sigmoidf_(g) * uu; }
                u32x4 w; w.x = cvt_pk_bf16(hv[0], hv[1]); w.y = cvt_pk_bf16(hv[2], hv[3]); w.z = cvt_pk_bf16(hv[4], hv[5]); w.w = cvt_pk_bf16(hv[6], hv[7]);
                *(u32x4*)(H + (size_t)row * DFF + col0) = w;
            }
        ZERO_ACC();
    }
};
struct EpiProj {
    bf16_t* P; int ldp; const float* rstd; const float* bgate; int gate_pn0;
    __device__ __forceinline__ void operator()(f32x4 (&acc)[2][2][4][2], const Unit& u, int wr, int wc, int fr, int fq, LAS unsigned char* lds, int wid, int lane) const {
        const int row0 = u.pm * BM + wr * 64 + fr, col0 = u.pn * BM + wc * 32 + 8 * fq; const bool gate = u.pn >= gate_pn0;
        f32x4 bv[2][2];
#pragma unroll
        for (int bj = 0; bj < 2; ++bj)
#pragma unroll
            for (int n = 0; n < 2; ++n) bv[bj][n] = gate ? *(const f32x4*)(bgate + (col0 - gate_pn0 * BM) + bj * HALF + 4 * n) : (f32x4){0.f, 0.f, 0.f, 0.f};
        float ssv[2][4];
#pragma unroll
        for (int ai = 0; ai < 2; ++ai)
#pragma unroll
            for (int m = 0; m < 4; ++m) ssv[ai][m] = rstd[row0 + ai * HALF + m * 16];
#pragma unroll
        for (int ai = 0; ai < 2; ++ai)
#pragma unroll
            for (int m = 0; m < 4; ++m) {
                const int row = row0 + ai * HALF + m * 16; const float rs = __builtin_amdgcn_rsqf(ssv[ai][m] * (1.0f / D) + EPS);
#pragma unroll
                for (int bj = 0; bj < 2; ++bj) {
                    f32x4 v0 = acc[ai][bj][m][0] * rs, v1 = acc[ai][bj][m][1] * rs;
                    if (gate) {
                        v0 = v0 + bv[bj][0]; v1 = v1 + bv[bj][1];
#pragma unroll
                        for (int j = 0; j < 4; ++j) { v0[j] = sigmoidf_(v0[j]); v1[j] = sigmoidf_(v1[j]); }
                    }
                    u32x4 w; w.x = cvt_pk_bf16(v0[0], v0[1]); w.y = cvt_pk_bf16(v0[2], v0[3]); w.z = cvt_pk_bf16(v1[0], v1[1]); w.w = cvt_pk_bf16(v1[2], v1[3]);
                    *(u32x4*)(P + (size_t)row * ldp + col0 + bj * HALF) = w;
                }
            }
        ZERO_ACC();
    }
};
constexpr int EPI_P_OFF = 131072, EPI_S_OFF = EPI_P_OFF + 4096;
struct EpiNormRes {
    const float* hprev; float* hout; const float* postw; unsigned char* wsb; int bank, rowbase, pmbase;
    __device__ __forceinline__ void operator()(f32x4 (&acc)[2][2][4][2], const Unit& u, int wr, int wc, int fr_, int fq_, LAS unsigned char* lds, int wid, int lane_) const {
        const int lane = fresh_lane(), fr = lane & 15, fq = lane >> 4; (void)fr_; (void)fq_; (void)lane_;
        LAS float* P = (LAS float*)(lds + EPI_P_OFF); LAS float* S = (LAS float*)(lds + EPI_S_OFF);
        const int pmg = pmbase + u.pm;
        float* const xbuf = (float*)(wsb + WS_STATS) + (size_t)bank * 262144; unsigned* const cnt = (unsigned*)(wsb + WS_CNT) + bank * 4096;
        bf16_t* const hb = bank < 2 ? (bf16_t*)(wsb + WS_AB) : nullptr; float* const ssn = bank == 0 ? (float*)(wsb + WS_SS2) : (bank == 1 ? (float*)(wsb + WS_SS3) : nullptr);
        const float scale = bank == 1 ? 1.0f : 0.5f;
        const int col0 = u.pn * BM + wc * 32 + 8 * fq;
        u32x2 yp[2][2][4][2];
#pragma unroll
        for (int ai = 0; ai < 2; ++ai)
#pragma unroll
            for (int m = 0; m < 4; ++m) {
                float q = 0.f;
#pragma unroll
                for (int bj = 0; bj < 2; ++bj)
#pragma unroll
                    for (int n = 0; n < 2; ++n) { const f32x4 v = acc[ai][bj][m][n]; q += (v[0] * v[0] + v[1] * v[1]) + (v[2] * v[2] + v[3] * v[3]);
                        yp[ai][bj][m][n] = (u32x2){pk2(v[0], v[1]), pk2(v[2], v[3])}; }
                q += shfl_xor_f(q, 16); q += shfl_xor_f(q, 32);
                if (fq == 0) P[(ai * HALF + wr * 64 + m * 16 + fr) * 4 + wc] = q;
            }
        f32x4 hp[4][2][2];
#pragma unroll
        for (int m = 0; m < 4; ++m) { const size_t off = (size_t)(rowbase + u.pm * BM + wr * 64 + m * 16 + fr) * D + col0;
#pragma unroll
            for (int bj = 0; bj < 2; ++bj) { hp[m][bj][0] = *(const f32x4*)(hprev + off + bj * HALF); hp[m][bj][1] = *(const f32x4*)(hprev + off + bj * HALF + 4); } }
        asm volatile("s_waitcnt lgkmcnt(0)" ::: "memory"); __builtin_amdgcn_s_barrier(); asm volatile("" ::: "memory");
        const int prow = wid * 32 + (lane & 31);
        float* slot = xbuf + ((size_t)pmg * 256 + prow) * 4;
        if (lane < 32) { const f32x4 pp = *(const LAS f32x4*)(P + prow * 4); __hip_atomic_store(slot + u.pn, (pp[0] + pp[1]) + (pp[2] + pp[3]), __ATOMIC_RELAXED, __HIP_MEMORY_SCOPE_AGENT); }
        asm volatile("s_waitcnt vmcnt(0)" ::: "memory");
        if (lane == 0) __hip_atomic_fetch_add(cnt + pmg * 16, 1u, __ATOMIC_RELAXED, __HIP_MEMORY_SCOPE_AGENT);
        if (wid == 0) {
            unsigned spins = 0;
            while ((unsigned)__builtin_amdgcn_readfirstlane((int)__hip_atomic_load(cnt + pmg * 16, __ATOMIC_RELAXED, __HIP_MEMORY_SCOPE_AGENT)) < 32u) { __builtin_amdgcn_s_sleep(1); if (++spins > (1u << 23)) break; }
            __builtin_amdgcn_fence(__ATOMIC_ACQUIRE, "agent");
            asm volatile("s_waitcnt vmcnt(0)" ::: "memory");
        }
        asm volatile("" ::: "memory"); __builtin_amdgcn_s_barrier(); asm volatile("" ::: "memory");
        if (lane < 32) {
            const float s0 = __hip_atomic_load(slot + 0, __ATOMIC_RELAXED, __HIP_MEMORY_SCOPE_AGENT), s1 = __hip_atomic_load(slot + 1, __ATOMIC_RELAXED, __HIP_MEMORY_SCOPE_AGENT),
                        s2 = __hip_atomic_load(slot + 2, __ATOMIC_RELAXED, __HIP_MEMORY_SCOPE_AGENT), s3 = __hip_atomic_load(slot + 3, __ATOMIC_RELAXED, __HIP_MEMORY_SCOPE_AGENT);
            S[prow] = 1.0f / sqrtf(((s0 + s1) + (s2 + s3)) * (1.0f / D) + EPS);
        }
        asm volatile("s_waitcnt vmcnt(0) lgkmcnt(0)" ::: "memory"); __builtin_amdgcn_s_barrier(); asm volatile("" ::: "memory");
        f32x4 pw[2][2];
#pragma unroll
        for (int bj = 0; bj < 2; ++bj)
#pragma unroll
            for (int n = 0; n < 2; ++n) pw[bj][n] = *(const f32x4*)(postw + col0 + bj * HALF + 4 * n) * scale;
#pragma unroll
        for (int ai = 0; ai < 2; ++ai) {
            if (ai == 1) {
#pragma unroll
                for (int m = 0; m < 4; ++m) { const size_t off = (size_t)(rowbase + u.pm * BM + HALF + wr * 64 + m * 16 + fr) * D + col0;
#pragma unroll
                    for (int bj = 0; bj < 2; ++bj) { hp[m][bj][0] = *(const f32x4*)(hprev + off + bj * HALF); hp[m][bj][1] = *(const f32x4*)(hprev + off + bj * HALF + 4); } }
            }
#pragma unroll
            for (int m = 0; m < 4; ++m) {
                const int rl = ai * HALF + wr * 64 + m * 16 + fr; const float rs = S[rl];
                const size_t off = (size_t)(rowbase + u.pm * BM + rl) * D + col0; float q2 = 0.f;
#pragma unroll
                for (int bj = 0; bj < 2; ++bj) {
                    const u32x2 y0 = yp[ai][bj][m][0], y1 = yp[ai][bj][m][1];
                    const f32x4 ya = (f32x4){bflo(y0.x), bfhi(y0.x), bflo(y0.y), bfhi(y0.y)}, yb = (f32x4){bflo(y1.x), bfhi(y1.x), bflo(y1.y), bfhi(y1.y)};
                    const f32x4 h0 = hp[m][bj][0] + pw[bj][0] * (ya * rs);
                    const f32x4 h1 = hp[m][bj][1] + pw[bj][1] * (yb * rs);
                    *(f32x4*)(hout + off + bj * HALF) = h0; *(f32x4*)(hout + off + bj * HALF + 4) = h1;
                    if (hb) { u32x4 w; w.x = pk2(h0[0], h0[1]); w.y = pk2(h0[2], h0[3]); w.z = pk2(h1[0], h1[1]); w.w = pk2(h1[2], h1[3]); *(u32x4*)(hb + off + bj * HALF) = w; }
                    q2 += (h0[0] * h0[0] + h0[1] * h0[1]) + (h0[2] * h0[2] + h0[3] * h0[3]) + (h1[0] * h1[0] + h1[1] * h1[1]) + (h1[2] * h1[2] + h1[3] * h1[3]);
                }
                if (ssn) { q2 += shfl_xor_f(q2, 16); q2 += shfl_xor_f(q2, 32); if (fq == 0) atomicAdd(ssn + rowbase + u.pm * BM + rl, q2); }
            }
        }
        ZERO_ACC();
    }
};
struct EpiMerge {
    const bf16_t* G; int ldg; bf16_t* YM; int ldy;
    __device__ __forceinline__ void operator()(f32x4 (&acc)[2][2][4][2], const Unit& u, int wr, int wc, int fr, int fq, LAS unsigned char* lds, int wid, int lane) const {
        const int row0 = u.pm * BM + wr * 64 + fr, col0 = u.pn * BM + wc * 32 + 8 * fq; const int seg = u.seg;
#pragma unroll
        for (int ai = 0; ai < 2; ++ai) {
            u32x4 gcv[4][2], gnv[4][2];
#pragma unroll
            for (int m = 0; m < 4; ++m)
#pragma unroll
                for (int bj = 0; bj < 2; ++bj) {
                    const bf16_t* gp = G + (size_t)(row0 + ai * HALF + m * 16) * ldg + seg * D + col0 + bj * HALF;
                    gcv[m][bj] = *(const u32x4*)gp; gnv[m][bj] = (u32x4){0u, 0u, 0u, 0u};
                    if (seg < 2) gnv[m][bj] = *(const u32x4*)(gp + D);
                }
#pragma unroll
            for (int m = 0; m < 4; ++m) {
                const int row = row0 + ai * HALF + m * 16;
#pragma unroll
                for (int bj = 0; bj < 2; ++bj) {
                    const u32x4 gc = gcv[m][bj];
                    float f[8] = {bflo(gc.x), bfhi(gc.x), bflo(gc.y), bfhi(gc.y), bflo(gc.z), bfhi(gc.z), bflo(gc.w), bfhi(gc.w)};
                    if (seg < 2) {
                        const u32x4 gn = gnv[m][bj];
                        const float d[8] = {bflo(gn.x), bfhi(gn.x), bflo(gn.y), bfhi(gn.y), bflo(gn.z), bfhi(gn.z), bflo(gn.w), bfhi(gn.w)};
#pragma unroll
                        for (int j = 0; j < 8; ++j) f[j] = f[j] * __builtin_amdgcn_rcpf(d[j]);
                    }
                    f32x4 v0 = acc[ai][bj][m][0], v1 = acc[ai][bj][m][1];
#pragma unroll
                    for (int j = 0; j < 4; ++j) { v0[j] *= f[j]; v1[j] *= f[4 + j]; }
                    if (seg == 2) {
                        u32x4 w; w.x = cvt_pk_bf16(v0[0], v0[1]); w.y = cvt_pk_bf16(v0[2], v0[3]); w.z = cvt_pk_bf16(v1[0], v1[1]); w.w = cvt_pk_bf16(v1[2], v1[3]);
                        *(u32x4*)(YM + (size_t)row * ldy + col0 + bj * HALF) = w;
                        v0 = (f32x4){0.f, 0.f, 0.f, 0.f}; v1 = v0;
                    }
                    acc[ai][bj][m][0] = v0; acc[ai][bj][m][1] = v1;
                }
            }
        }
    }
};

#ifndef PG8_SP2
#define PG8_SP2 1
#endif
template <class Epi, int NSEG>
__device__ __forceinline__ void gemm_phase(LAS unsigned char* lds, const Gemm g, const OrderT<NSEG>& S, const Epi& E, const int wid) {
    const int lane = fresh_lane(), tid = wid * 64 + lane, wr = wid >> 2, wc = wid & 3, fr = lane & 15, fq = lane >> 4;
    const int K = g.K, nt = K / BK;
    unsigned voffA[2], voffB[2];
#pragma unroll
    for (int i = 0; i < 2; ++i) { int R, C; stage_rc(tid * 16 + i * 8192, R, C); const int Rb = (R & ~31) + perm32(R & 31);
        voffA[i] = (unsigned)(R * g.lda + C) * 2u; voffB[i] = (unsigned)(Rb * g.ldb + C) * 2u; }
    const size_t kstep = (size_t)(BK * 2);
    const size_t hstepA = (size_t)HALF * g.lda * 2, hstepB = (size_t)HALF * g.ldb * 2;
    const size_t tstepA = 2 * hstepA, tstepB = 2 * hstepB;
    const unsigned ldsw = (unsigned)wid * 1024u;
    const int aoff = lds_byte(wr * 64 + fr, fq * 8), boff = lds_byte(wc * 32 + fr, fq * 8);
#define PG8_SA(b, h) (((b) * 2 + (h)) * HTB)
#define PG8_SB(b, h) ((4 + (b) * 2 + (h)) * HTB)
#define PG8_STAGE(bufoff, gbase, voff) do { _Pragma("unroll") for (int _i = 0; _i < 2; ++_i) \
        __builtin_amdgcn_global_load_lds((const unsigned*)((const char*)(gbase) + (voff)[_i]), (LAS unsigned*)(lds + (bufoff) + ldsw + _i * 8192), 16, 0, 0); } while (0)
#define PG8_LDA(dst, b, h) do { _Pragma("unroll") for (int m = 0; m < 4; ++m) _Pragma("unroll") for (int k = 0; k < 2; ++k) dst[m][k] = *(const LAS bf16x8*)(lds + PG8_SA(b, h) + aoff + m * 2048 + k * 1024); } while (0)
#define PG8_LDB(dst, b, h) do { _Pragma("unroll") for (int n = 0; n < 2; ++n) _Pragma("unroll") for (int k = 0; k < 2; ++k) dst[n][k] = *(const LAS bf16x8*)(lds + PG8_SB(b, h) + boff + n * 2048 + k * 1024); } while (0)
#define PG8_MMA(ai, bj, At, Bt) do { __builtin_amdgcn_s_setprio(1); _Pragma("unroll") for (int m = 0; m < 4; ++m) _Pragma("unroll") for (int n = 0; n < 2; ++n) _Pragma("unroll") for (int k = 0; k < 2; ++k) \
        acc[ai][bj][m][n] = __builtin_amdgcn_mfma_f32_16x16x32_bf16(Bt[n][k], At[m][k], acc[ai][bj][m][n], 0, 0, 0); __builtin_amdgcn_s_setprio(0); } while (0)
#define PG8_WAIT_V(n) asm volatile("s_waitcnt vmcnt(" #n ")" ::: "memory")
#define PG8_WAIT_L(n) asm volatile("s_waitcnt lgkmcnt(" #n ")" ::: "memory")
#define PG8_BAR __builtin_amdgcn_s_barrier()
#define PG8_SCHED __builtin_amdgcn_sched_barrier(0)
#define PG8_APTR(u) ((const char*)((NSEG == 1 || (u).seg == 0) ? g.A0 : ((u).seg == 1 ? g.A1 : g.A2)) + (size_t)(u).pm * tstepA)
#define PG8_BPTR(u) ((const char*)((NSEG == 1 || (u).seg == 0) ? g.B0 : ((u).seg == 1 ? g.B1 : g.B2)) + (size_t)(u).pn * tstepB)
    Unit cur, nxt; int ui = 0;
    if (!S.next(0, cur)) return;
    f32x4 acc[2][2][4][2];
    ZERO_ACC();
    bf16x8 At[4][2], B0[2][2], B1[2][2];
    const char* cA = PG8_APTR(cur); const char* cB = PG8_BPTR(cur);
    if constexpr (PG8_SP2) {
    PG8_STAGE(PG8_SB(0, 0), cB, voffB); PG8_STAGE(PG8_SB(0, 1), cB + hstepB, voffB); PG8_STAGE(PG8_SA(0, 0), cA, voffA); PG8_STAGE(PG8_SA(0, 1), cA + hstepA, voffA);
    if (wr == 1) PG8_BAR;
    PG8_WAIT_V(2); PG8_BAR;
    PG8_STAGE(PG8_SB(1, 0), cB + kstep, voffB); PG8_STAGE(PG8_SA(1, 0), cA + kstep, voffA); PG8_STAGE(PG8_SB(1, 1), cB + hstepB + kstep, voffB);
    PG8_WAIT_V(6); PG8_BAR;
    } else {
    PG8_STAGE(PG8_SB(0, 0), cB, voffB); PG8_STAGE(PG8_SA(0, 0), cA, voffA); PG8_STAGE(PG8_SB(0, 1), cB + hstepB, voffB); PG8_STAGE(PG8_SA(0, 1), cA + hstepA, voffA);
    if (wr == 1) PG8_BAR;
    PG8_WAIT_V(4); PG8_BAR;
    PG8_STAGE(PG8_SB(1, 0), cB + kstep, voffB); PG8_STAGE(PG8_SA(1, 0), cA + kstep, voffA); PG8_STAGE(PG8_SB(1, 1), cB + hstepB + kstep, voffB);
    PG8_WAIT_V(6); PG8_BAR;
    }
    for (;;) {
        const bool has_next = S.next(ui + 1, nxt);
        const char* nA = has_next ? PG8_APTR(nxt) : cA; const char* nB = has_next ? PG8_BPTR(nxt) : cB;
        for (int t = 0; t < nt; t += 2) {
            const bool last = (t == nt - 2);
            const char* a1 = cA + (size_t)(t + 1) * kstep;
            const char* a2 = last ? nA : cA + (size_t)(t + 2) * kstep; const char* b2 = last ? nB : cB + (size_t)(t + 2) * kstep;
            const char* a3 = a2 + kstep; const char* b3 = b2 + kstep;
            if constexpr (!PG8_SP2) {
            PG8_LDB(B0, 0, 0); PG8_SCHED; PG8_LDA(At, 0, 0); PG8_STAGE(PG8_SA(1, 1), a1 + hstepA, voffA);
            PG8_WAIT_L(8); PG8_BAR; PG8_WAIT_L(0); PG8_MMA(0, 0, At, B0); PG8_BAR; PG8_SCHED;
            PG8_LDB(B1, 0, 1); PG8_STAGE(PG8_SB(0, 0), b2, voffB);
            PG8_BAR; PG8_WAIT_L(0); PG8_MMA(0, 1, At, B1); PG8_BAR;
            PG8_LDA(At, 0, 1); PG8_STAGE(PG8_SA(0, 0), a2, voffA);
            PG8_BAR; PG8_WAIT_L(0); PG8_MMA(1, 0, At, B0); PG8_BAR; PG8_SCHED;
            PG8_STAGE(PG8_SB(0, 1), b2 + hstepB, voffB);
            PG8_WAIT_V(6); PG8_BAR; PG8_MMA(1, 1, At, B1); PG8_BAR;
            PG8_LDB(B0, 1, 0); PG8_SCHED; PG8_LDA(At, 1, 0); PG8_STAGE(PG8_SA(0, 1), a2 + hstepA, voffA);
            PG8_WAIT_L(8); PG8_BAR; PG8_WAIT_L(0); PG8_MMA(0, 0, At, B0); PG8_BAR; PG8_SCHED;
            PG8_LDB(B1, 1, 1); PG8_STAGE(PG8_SB(1, 0), b3, voffB);
            PG8_BAR; PG8_WAIT_L(0); PG8_MMA(0, 1, At, B1); PG8_BAR;
            PG8_LDA(At, 1, 1); PG8_STAGE(PG8_SA(1, 0), a3, voffA);
            PG8_BAR; PG8_WAIT_L(0); PG8_MMA(1, 0, At, B0); PG8_BAR; PG8_SCHED;
            PG8_STAGE(PG8_SB(1, 1), b3 + hstepB, voffB);
            PG8_WAIT_V(6); PG8_BAR; PG8_MMA(1, 1, At, B1); PG8_BAR;
            } else {
            PG8_LDB(B0, 0, 0); PG8_LDB(B1, 0, 1); PG8_SCHED; PG8_LDA(At, 0, 0); PG8_STAGE(PG8_SA(1, 1), a1 + hstepA, voffA);
            PG8_WAIT_V(8); PG8_WAIT_L(0); PG8_BAR; PG8_MMA(0, 0, At, B0); PG8_MMA(0, 1, At, B1); PG8_BAR; PG8_SCHED;
            PG8_LDA(At, 0, 1); PG8_STAGE(PG8_SB(0, 0), b2, voffB); PG8_STAGE(PG8_SB(0, 1), b2 + hstepB, voffB); PG8_STAGE(PG8_SA(0, 0), a2, voffA);
            PG8_WAIT_V(8); PG8_WAIT_L(0); PG8_BAR; PG8_MMA(1, 0, At, B0); PG8_MMA(1, 1, At, B1); PG8_BAR; PG8_SCHED;
            PG8_LDB(B0, 1, 0); PG8_LDB(B1, 1, 1); PG8_SCHED; PG8_LDA(At, 1, 0); PG8_STAGE(PG8_SA(0, 1), a2 + hstepA, voffA);
            PG8_WAIT_V(8); PG8_WAIT_L(0); PG8_BAR; PG8_MMA(0, 0, At, B0); PG8_MMA(0, 1, At, B1); PG8_BAR; PG8_SCHED;
            PG8_LDA(At, 1, 1); PG8_STAGE(PG8_SB(1, 0), b3, voffB); PG8_STAGE(PG8_SB(1, 1), b3 + hstepB, voffB); PG8_STAGE(PG8_SA(1, 0), a3, voffA);
            PG8_WAIT_V(8); PG8_WAIT_L(0); PG8_BAR; PG8_MMA(1, 0, At, B0); PG8_MMA(1, 1, At, B1); PG8_BAR; PG8_SCHED;
            }
        }
        if (wr == 0) PG8_BAR;
        E(acc, cur, wr, wc, fr, fq, lds, wid, lane);
        if (!has_next) break;
        cur = nxt; cA = nA; cB = nB; ++ui;
        if (wr == 1) PG8_BAR;
    }
    PG8_WAIT_V(0);
    PG8_BAR;
#undef PG8_SA
#undef PG8_SB
#undef PG8_STAGE
#undef PG8_LDA
#undef PG8_LDB
#undef PG8_MMA
#undef PG8_WAIT_V
#undef PG8_WAIT_L
#undef PG8_BAR
#undef PG8_SCHED
#undef PG8_APTR
#undef PG8_BPTR
}
}

__device__ __forceinline__ void tr_item(const float* W, int ldw, const float* ksc, bf16_t* WT, int K, int k0, int n0_dst, int n0_src, LAS float* scr, int lane) {
    float wv[32];
#pragma unroll
    for (int i = 0; i < 32; ++i) { const int kk = 2 * i + (lane >> 5); wv[i] = W[(size_t)(k0 + kk) * ldw + n0_src + (lane & 31)]; }
#pragma unroll
    for (int i = 0; i < 32; ++i) { const int kk = 2 * i + (lane >> 5); const float s = ksc ? ksc[k0 + kk] : 1.0f; scr[kk * 33 + (lane & 31)] = wv[i] * s; }
    asm volatile("s_waitcnt lgkmcnt(0)" ::: "memory");
    const int c = lane & 7;
#pragma unroll
    for (int j = 0; j < 4; ++j) { const int n = (lane >> 3) + 8 * j; const LAS float* s = scr + (8 * c) * 33 + n;
        u32x4 o; o.x = pk2(s[0 * 33], s[1 * 33]); o.y = pk2(s[2 * 33], s[3 * 33]); o.z = pk2(s[4 * 33], s[5 * 33]); o.w = pk2(s[6 * 33], s[7 * 33]);
        *(u32x4*)(WT + (size_t)(n0_dst + n) * K + k0 + 8 * c) = o; }
    asm volatile("s_waitcnt lgkmcnt(0)" ::: "memory");
}
__device__ __forceinline__ void tr_weight(const float* W, int ldw, const float* ksc, bf16_t* WT, int K, int N, int gu, int item, LAS float* scr, int lane) {
    const int nblk = N / 32, kb = item / nblk, nb = item % nblk, n0 = 32 * nb;
    int n0s = n0;
    if (gu) { const int blk = n0 >> 7, pn = blk >> 1, bj = blk & 1; n0s = bj * DFF + pn * 128 + (n0 & 127); }
    tr_item(W, ldw, ksc, WT, K, 64 * kb, n0, n0s, scr, lane);
}
__device__ __forceinline__ void row2_to_bf16_ss(const float* x0, const float* x1, bf16_t* o0, bf16_t* o1, float* ss0, float* ss1, int lane) {
    const f32x4* xa = (const f32x4*)x0 + lane; const f32x4* xb = (const f32x4*)x1 + lane; f32x4 va[4], vb[4]; float sa = 0.f, sb = 0.f;
#pragma unroll
    for (int j = 0; j < 4; ++j) { va[j] = xa[64 * j]; vb[j] = xb[64 * j]; }
#pragma unroll
    for (int j = 0; j < 4; ++j) { sa += (va[j].x * va[j].x + va[j].y * va[j].y) + (va[j].z * va[j].z + va[j].w * va[j].w); sb += (vb[j].x * vb[j].x + vb[j].y * vb[j].y) + (vb[j].z * vb[j].z + vb[j].w * vb[j].w); }
    sa = wave_sum(sa); sb = wave_sum(sb);
    if (lane == 0) { *ss0 = sa; *ss1 = sb; }
    unsigned long long* pa = (unsigned long long*)o0 + lane; unsigned long long* pb = (unsigned long long*)o1 + lane;
#pragma unroll
    for (int j = 0; j < 4; ++j) { pa[64 * j] = (unsigned long long)pk2(va[j].x, va[j].y) | ((unsigned long long)pk2(va[j].z, va[j].w) << 32);
                                  pb[64 * j] = (unsigned long long)pk2(vb[j].x, vb[j].y) | ((unsigned long long)pk2(vb[j].z, vb[j].w) << 32); }
}
__device__ __forceinline__ void row_to_bf16_rstd(const float* xrow, bf16_t* orow, float* rstd_out, int lane) {
    const f32x4* xr = (const f32x4*)xrow + lane; f32x4 v[4]; float s = 0.f;
#pragma unroll
    for (int j = 0; j < 4; ++j) { v[j] = xr[64 * j]; s += (v[j].x * v[j].x + v[j].y * v[j].y) + (v[j].z * v[j].z + v[j].w * v[j].w); }
    s = wave_sum(s);
    if (lane == 0) *rstd_out = s;
    unsigned long long* o8 = (unsigned long long*)orow + lane;
#pragma unroll
    for (int j = 0; j < 4; ++j) o8[64 * j] = (unsigned long long)pk2(v[j].x, v[j].y) | ((unsigned long long)pk2(v[j].z, v[j].w) << 32);
}

#define LDS_BAR() do { asm volatile("s_waitcnt lgkmcnt(0)" ::: "memory"); __builtin_amdgcn_s_barrier(); asm volatile("" ::: "memory"); } while (0)
#define MFMA32(a, b, c) __builtin_amdgcn_mfma_f32_32x32x16_bf16((a), (b), (c), 0, 0, 0)
constexpr int KS_PITCH = 272, VT_PITCH = 520, VT_OFF = 256 * KS_PITCH  , MX_OFF = VT_OFF + 128 * VT_PITCH  , OS_PITCH = 272;
static_assert(MX_OFF + 2048 <= MISC_OFF, "attention LDS");
__device__ __forceinline__ void attn_unit(LAS unsigned char* lds, const bf16_t* Q, size_t qstride, const bf16_t* Kp, const bf16_t* Vp, size_t kstride,
                                          int kvalid0, int dilmode, float c_scale, float c_alibi, float* stats, size_t sstride, int tid) {
    const int lane = tid & 63, wave = __builtin_amdgcn_readfirstlane(tid >> 6), qt = wave & 3, kh = wave >> 2, r = lane & 31, h = lane >> 5;
    LAS unsigned char* Ks = lds; LAS unsigned char* Vt = lds + VT_OFF; LAS float* MX = (LAS float*)(lds + MX_OFF); LAS float* SM = MX + 256;
    u32x4 kv[8]; u32x4 vv[2][4]; bf16x8 qf[8];
    {
        const int t1 = wave * 64 + fresh_lane();
#pragma unroll
        for (int i = 0; i < 8; ++i) { const int c = t1 + 512 * i, row = c >> 4, cc = c & 15;
            kv[i] = (u32x4){0u, 0u, 0u, 0u};
            if (kvalid0 || i >= 4) kv[i] = *(const u32x4*)(Kp + (ptrdiff_t)row * (ptrdiff_t)kstride + cc * 8); }
#pragma unroll
        for (int i = 0; i < 2; ++i) { const int w = wave + 8 * i, kg = (w & 7) * 8 + (lane & 7), dg = (w >> 3) * 8 + (lane >> 3);
#pragma unroll
            for (int j = 0; j < 4; ++j) { vv[i][j] = (u32x4){0u, 0u, 0u, 0u};
                if (kvalid0 || (w & 7) >= 4) vv[i][j] = *(const u32x4*)(Vp + (ptrdiff_t)(4 * kg + j) * (ptrdiff_t)kstride + dg * 8); } }
#pragma unroll
        for (int s = 0; s < 8; ++s) qf[s] = *(const bf16x8*)(Q + (size_t)(qt * 32 + r) * qstride + 16 * s + 8 * h);
#pragma unroll
        for (int i = 0; i < 8; ++i) { const int c = t1 + 512 * i, row = c >> 4, cc = c & 15; *(LAS u32x4*)(Ks + row * KS_PITCH + cc * 16) = kv[i]; }
#pragma unroll
        for (int i = 0; i < 2; ++i) { const int w = wave + 8 * i, kg = (w & 7) * 8 + (lane & 7), dg = (w >> 3) * 8 + (lane >> 3);
#pragma unroll
            for (int q = 0; q < 4; ++q) { const unsigned a = vv[i][0][q], b = vv[i][1][q], c = vv[i][2][q], d = vv[i][3][q];
                u32x2 e, o; e.x = (a & 0xffffu) | (b << 16); e.y = (c & 0xffffu) | (d << 16); o.x = (a >> 16) | (b & 0xffff0000u); o.y = (c >> 16) | (d & 0xffff0000u);
                *(LAS u32x2*)(Vt + (dg * 8 + 2 * q) * VT_PITCH + kg * 8) = e; *(LAS u32x2*)(Vt + (dg * 8 + 2 * q + 1) * VT_PITCH + kg * 8) = o; } }
    }
    LDS_BAR();
    const int NS = dilmode ? 3 : 4;
    int tb[4]; bool tv[4];
    {
        const int P = kvalid0 ? 4 - qt : 0, L = P + qt + 1, n0 = (L + 1) >> 1, e0 = kh == 0 ? 0 : n0, e1 = kh == 0 ? n0 : L;
#pragma unroll
        for (int j = 0; j < 4; ++j) {
            if (dilmode) { const int e = e0 + j; tv[j] = e < e1; const int ee = tv[j] ? e : 0; tb[j] = ee < P ? (qt + ee) * 32 : 128 + (ee - P) * 32; }
            else { tv[j] = true; tb[j] = (kh * 4 + j) * 32; }
        }
    }
    f32x16 acc[4];
    const int qi = qt * 32 + r; float mloc = -1e30f;
#pragma unroll
    for (int j = 0; j < 4; ++j)
#pragma unroll
        for (int i = 0; i < 16; ++i) acc[j][i] = 0.f;
#pragma unroll
    for (int s = 0; s < 8; ++s)
#pragma unroll
        for (int j = 0; j < 4; ++j)
            if (j < NS) { const bf16x8 a = *(const LAS bf16x8*)(Ks + (tb[j] + r) * KS_PITCH + (16 * s + 8 * h) * 2); acc[j] = MFMA32(a, qf[s], acc[j]); }
#pragma unroll
    for (int j = 0; j < 4; ++j)
        if (j < NS) {
#pragma unroll
            for (int i = 0; i < 16; ++i) {
                float sv = acc[j][i] * c_scale;
                if (dilmode) {
                    const int delta = 128 + qi - (tb[j] + (i & 3) + 8 * (i >> 2) + 4 * h);
                    sv = (tv[j] && (unsigned)delta <= 128u) ? sv - c_alibi * (float)delta : -1e30f;
                }
                acc[j][i] = sv; mloc = fmaxf(mloc, sv);
            }
        }
    mloc = fmaxf(mloc, shfl_xor_f(mloc, 32));
    if (h == 0) MX[kh * 128 + qi] = mloc;
    LDS_BAR();
    const float mfin = fmaxf(MX[qi], MX[128 + qi]);
    float ssum = 0.f;
#pragma unroll
    for (int j = 0; j < 4; ++j)
        if (j < NS) {
#pragma unroll
            for (int i = 0; i < 16; ++i) { const float p = __builtin_amdgcn_exp2f(acc[j][i] - mfin); acc[j][i] = p; ssum += p; }
        }
    ssum += shfl_xor_f(ssum, 32);
    if (h == 0) SM[kh * 128 + qi] = ssum;
    f32x16 o[4];
#pragma unroll
    for (int dt = 0; dt < 4; ++dt)
#pragma unroll
        for (int i = 0; i < 16; ++i) o[dt][i] = 0.f;
#pragma unroll
    for (int j = 0; j < 4; ++j)
        if (j < NS) {
#pragma unroll
            for (int s = 0; s < 2; ++s) {
                u32x4 pp; pp.x = pk2(acc[j][8 * s + 0], acc[j][8 * s + 1]); pp.y = pk2(acc[j][8 * s + 2], acc[j][8 * s + 3]); pp.z = pk2(acc[j][8 * s + 4], acc[j][8 * s + 5]); pp.w = pk2(acc[j][8 * s + 6], acc[j][8 * s + 7]);
                const bf16x8 pa = __builtin_bit_cast(bf16x8, pp);
#pragma unroll
                for (int dt = 0; dt < 4; ++dt) {
                    const LAS unsigned char* vp = Vt + (dt * 32 + r) * VT_PITCH + (tb[j] + 16 * s + 4 * h) * 2;
                    const u32x2 lo = *(const LAS u32x2*)vp, hi = *(const LAS u32x2*)(vp + 16);
                    const u32x4 bb = (u32x4){lo.x, lo.y, hi.x, hi.y};
                    o[dt] = MFMA32(pa, __builtin_bit_cast(bf16x8, bb), o[dt]);
                }
            }
        }
    LAS float* EX = (LAS float*)Ks;
    const int lane_l = fresh_lane();
#define ATT_TAIL(M0, M1, X0, X1) do { \
        _Pragma("unroll") for (int i = 0; i < 16; ++i) { EX[((wave * 2 + 0) * 16 + i) * 64 + lane_l] = o[X0][i]; EX[((wave * 2 + 1) * 16 + i) * 64 + lane_l] = o[X1][i]; } \
        LDS_BAR();                                         \
        { const int r = lane_l & 31, h = lane_l >> 5, pw_ = (wave ^ 4); \
          _Pragma("unroll") for (int i = 0; i < 16; ++i) { \
            const int qrow = qt * 32 + (i & 3) + 8 * (i >> 2) + 4 * h; \
            const float l = SM[qrow] + SM[128 + qrow]; const float inv = __builtin_amdgcn_rcpf(l); \
            const float v0 = (o[M0][i] + EX[((pw_ * 2 + 0) * 16 + i) * 64 + lane_l]) * inv, v1 = (o[M1][i] + EX[((pw_ * 2 + 1) * 16 + i) * 64 + lane_l]) * inv; \
            *(LAS bf16_t*)(OS + qrow * OS_PITCH + ((M0) * 32 + r) * 2) = (bf16_t)f2bf(v0); *(LAS bf16_t*)(OS + qrow * OS_PITCH + ((M1) * 32 + r) * 2) = (bf16_t)f2bf(v1); \
            if (kh == 0 && stats != nullptr && r == 0) { float* sp = stats + (size_t)qrow * sstride; sp[0] = fmaxf(MX[qrow], MX[128 + qrow]); sp[1] = l; } \
          } } } while (0)
    LAS unsigned char* OS = Vt;
    if (kh == 0) ATT_TAIL(0, 1, 2, 3); else ATT_TAIL(2, 3, 0, 1);
#undef ATT_TAIL
    LDS_BAR();
    { const int t2 = wave * 64 + fresh_lane();
#pragma unroll
    for (int i = 0; i < 4; ++i) { const int c = t2 + 512 * i, row = c >> 4, cc = c & 15; const u32x4 v = *(const LAS u32x4*)(OS + row * OS_PITCH + cc * 16); *(u32x4*)((bf16_t*)Q + (size_t)row * qstride + cc * 8) = v; } }
    LDS_BAR();
}

__device__ __forceinline__ int hg_permpos(int col) { const int w = col & 15; return (col & ~15) + 8 * ((w >> 2) & 1) + 4 * (w >> 3) + (w & 3); }
struct HgRaw { unsigned fr[16], qr[16], vr[16]; };
__device__ __forceinline__ void hgA_load(HgRaw& w, const bf16_t* P, int h, int tid) {
    const int col = tid & 127, tg = tid >> 7;
#pragma unroll
    for (int j = 0; j < 16; ++j) { const bf16_t* pr = P + (size_t)(tg * 16 + j) * PITCH + h * 128 + col; w.qr[j] = pr[C_HQ]; w.vr[j] = pr[C_HI]; }
#pragma unroll
    for (int j = 0; j < 16; ++j) { const bf16_t* pr = P + (size_t)(tg * 16 + j) * PITCH + h * 128 + col; w.fr[j] = pr[C_HF]; }
}
__device__ __forceinline__ void hgA_unit(LAS unsigned char* lds, const HgRaw& w, bf16_t* P, int h, const float* lb_logits, bf16_t* KT, bf16_t* VTg, bf16_t* SC, float* DD, int tid) {
    LAS float* TOT = (LAS float*)lds; LAS unsigned char* QT = lds + 2048; LAS unsigned char* KL = lds + 2048 + 64 * 272;
    const int col = tid & 127, tg = tid >> 7, lane = tid & 63, wave = __builtin_amdgcn_readfirstlane(tid >> 6);
    const float a0 = lb_logits[h * 128 + col], a1 = lb_logits[512 + h * 128 + col]; const float lb = 1.0f / (1.0f + __expf(a1 - a0));
    const unsigned (&fr)[16] = w.fr; const unsigned (&qr)[16] = w.qr; const unsigned (&vr)[16] = w.vr;
    float f[16], p[16]; float run = 0.f;
#pragma unroll
    for (int j = 0; j < 16; ++j) { f[j] = lb + (1.0f - lb) * sigmoidf_(bflo(fr[j])); run += __logf(f[j]); p[j] = run; }
    TOT[tg * 128 + col] = run;
    LDS_BAR();
    const float t0 = TOT[col], t1 = TOT[128 + col], t2 = TOT[256 + col], t3 = TOT[384 + col];
    const float off = (tg > 0 ? t0 : 0.f) + (tg > 1 ? t1 : 0.f) + (tg > 2 ? t2 : 0.f), ref = t0 + t1, blast = (t0 + t1) + (t2 + t3);
    const int pcol = hg_permpos(col);
    unsigned kp[8];
#pragma unroll
    for (int j = 0; j < 16; ++j) {
        const int row = tg * 16 + j; const float b = off + p[j], qv = bflo(qr[j]), q = qv * sigmoidf_(qv), k = 1.0f - f[j];
        *(LAS bf16_t*)(QT + row * 272 + col * 2) = (bf16_t)f2bf(q * __expf(b - ref));
        *(LAS bf16_t*)(KL + row * 272 + col * 2) = (bf16_t)f2bf(k * __expf(ref - b));
        P[(size_t)row * PITCH + C_HQ + h * 128 + pcol] = (bf16_t)f2bf(q * __expf(b));
        const unsigned kb = f2bf(k * __expf(blast - b));
        if (j & 1) kp[j >> 1] |= kb << 16; else kp[j >> 1] = kb;
    }
    { u32x4* kd = (u32x4*)(KT + col * 64 + tg * 16); kd[0] = (u32x4){kp[0], kp[1], kp[2], kp[3]}; kd[1] = (u32x4){kp[4], kp[5], kp[6], kp[7]};
      unsigned vp[8];
#pragma unroll
      for (int j = 0; j < 8; ++j) vp[j] = vr[2 * j] | (vr[2 * j + 1] << 16);
      u32x4* vd = (u32x4*)(VTg + col * 64 + tg * 16); vd[0] = (u32x4){vp[0], vp[1], vp[2], vp[3]}; vd[1] = (u32x4){vp[4], vp[5], vp[6], vp[7]};
      if (tg == 0) DD[col] = __expf(blast); }
    LDS_BAR();
    if (wave < 4) {
        const int ctile = wave >> 1, stile = wave & 1, r = lane & 31, hh = lane >> 5;
        f32x16 acc;
#pragma unroll
        for (int i = 0; i < 16; ++i) acc[i] = 0.f;
#pragma unroll
        for (int ks = 0; ks < 8; ++ks) {
            const bf16x8 av = *(const LAS bf16x8*)(QT + (ctile * 32 + r) * 272 + (16 * ks + 8 * hh) * 2);
            const bf16x8 bv = *(const LAS bf16x8*)(KL + (stile * 32 + r) * 272 + (16 * ks + 8 * hh) * 2);
            acc = MFMA32(av, bv, acc);
        }
        const int sabs = stile * 32 + r;
#pragma unroll
        for (int i = 0; i < 16; ++i) { const int cabs = ctile * 32 + (i & 3) + 8 * (i >> 2) + 4 * hh; SC[cabs * 64 + sabs] = (bf16_t)f2bf(sabs <= cabs ? acc[i] : 0.f); }
    }
    LDS_BAR();
}
constexpr int HB_QP = 0, HB_KT = 64 * 272, HB_VT = HB_KT + 128 * 144, HB_SC = HB_VT + 128 * 144, HB_D = HB_SC + 64 * 144, HB_BUF = HB_D + 512;
static_assert(2 * HB_BUF <= MISC_OFF, "hgB LDS");
__device__ __forceinline__ void hgB_unit(LAS unsigned char* lds, bf16_t* Pb, int h, const bf16_t* KT, const bf16_t* VTg, const bf16_t* SC, const float* DD, int tid) {
    const int lane = tid & 63, wave = __builtin_amdgcn_readfirstlane(tid >> 6), dvt = wave & 3, ct = wave >> 2, r = lane & 31, hh = lane >> 5;
    f32x16 S[4];
#pragma unroll
    for (int t = 0; t < 4; ++t)
#pragma unroll
        for (int i = 0; i < 16; ++i) S[t][i] = 0.f;
    u32x4 pq[2], pk[2], pv[2], ps, pd;
#define HB_LOAD(n) do { \
        _Pragma("unroll") for (int i_ = 0; i_ < 2; ++i_) { const int idx = tid + 512 * i_; \
            pq[i_] = *(const u32x4*)(Pb + (size_t)((n) * 64 + (idx >> 4)) * PITCH + C_HQ + h * 128 + (idx & 15) * 8); \
            pk[i_] = *(const u32x4*)(KT + (size_t)(n) * 4 * 8192 + idx * 8); pv[i_] = *(const u32x4*)(VTg + (size_t)(n) * 4 * 8192 + idx * 8); } \
        ps = *(const u32x4*)(SC + (size_t)(n) * 4 * 4096 + tid * 8); \
        if (tid < 32) pd = *(const u32x4*)(DD + (size_t)(n) * 4 * 128 + tid * 4); } while (0)
#define HB_WRITE(buf) do { LAS unsigned char* B_ = lds + (buf) * HB_BUF; \
        _Pragma("unroll") for (int i_ = 0; i_ < 2; ++i_) { const int idx = tid + 512 * i_; \
            *(LAS u32x4*)(B_ + HB_QP + (idx >> 4) * 272 + (idx & 15) * 16) = pq[i_]; \
            *(LAS u32x4*)(B_ + HB_KT + (idx >> 3) * 144 + (idx & 7) * 16) = pk[i_]; *(LAS u32x4*)(B_ + HB_VT + (idx >> 3) * 144 + (idx & 7) * 16) = pv[i_]; } \
        *(LAS u32x4*)(B_ + HB_SC + (tid >> 3) * 144 + (tid & 7) * 16) = ps; \
        if (tid < 32) *(LAS u32x4*)(B_ + HB_D + tid * 16) = pd; } while (0)
    HB_LOAD(0); HB_WRITE(0);
    LDS_BAR();
#ifndef HB_REP
#define HB_REP 1
#endif
    for (int nn = 0; nn < 64 * HB_REP; ++nn) {
        const int n = nn & 63;
        if (HB_REP > 1 && n == 0) {
#pragma unroll
            for (int t = 0; t < 4; ++t)
#pragma unroll
                for (int i = 0; i < 16; ++i) S[t][i] = 0.f;
        }
        if (nn + 1 < 64 * HB_REP) HB_LOAD((nn + 1) & 63);
        const LAS unsigned char* B = lds + (n & 1) * HB_BUF;
        bf16x8 vb[4];
#pragma unroll
        for (int ks = 0; ks < 4; ++ks) vb[ks] = *(const LAS bf16x8*)(B + HB_VT + (dvt * 32 + r) * 144 + (16 * ks + 8 * hh) * 2);
        f32x16 O, O2;
#pragma unroll
        for (int i = 0; i < 16; ++i) { O[i] = 0.f; O2[i] = 0.f; }
#pragma unroll
        for (int ks = 0; ks < 4; ++ks) { const bf16x8 av = *(const LAS bf16x8*)(B + HB_SC + (ct * 32 + r) * 144 + (16 * ks + 8 * hh) * 2); O2 = MFMA32(av, vb[ks], O2); }
#pragma unroll
        for (int t = 0; t < 4; ++t)
#pragma unroll
            for (int s2 = 0; s2 < 2; ++s2) {
                u32x4 xp; xp.x = pk2(S[t][8 * s2 + 0], S[t][8 * s2 + 1]); xp.y = pk2(S[t][8 * s2 + 2], S[t][8 * s2 + 3]); xp.z = pk2(S[t][8 * s2 + 4], S[t][8 * s2 + 5]); xp.w = pk2(S[t][8 * s2 + 6], S[t][8 * s2 + 7]);
                const bf16x8 av = *(const LAS bf16x8*)(B + HB_QP + (ct * 32 + r) * 272 + (32 * t + 16 * s2 + 8 * hh) * 2);
                if (t & 1) O2 = MFMA32(av, __builtin_bit_cast(bf16x8, xp), O2); else O = MFMA32(av, __builtin_bit_cast(bf16x8, xp), O);
            }
#pragma unroll
        for (int i = 0; i < 16; ++i) O[i] += O2[i];
#pragma unroll
        for (int t = 0; t < 4; ++t) {
#pragma unroll
            for (int a4 = 0; a4 < 4; ++a4) { const f32x4 dd = *(const LAS f32x4*)(B + HB_D + (32 * t + 8 * a4 + 4 * hh) * 4);
#pragma unroll
                for (int b = 0; b < 4; ++b) S[t][4 * a4 + b] *= dd[b]; }
#pragma unroll
            for (int ks = 0; ks < 4; ++ks) { const bf16x8 av = *(const LAS bf16x8*)(B + HB_KT + (32 * t + r) * 144 + (16 * ks + 8 * hh) * 2); S[t] = MFMA32(av, vb[ks], S[t]); }
        }
        if (nn + 1 < 64 * HB_REP) HB_WRITE((n + 1) & 1);
#pragma unroll
        for (int i = 0; i < 16; ++i) Pb[(size_t)(n * 64 + ct * 32 + (i & 3) + 8 * (i >> 2) + 4 * hh) * PITCH + C_HI + h * 128 + dvt * 32 + r] = (bf16_t)f2bf(O[i]);
        LDS_BAR();
    }
#undef HB_LOAD
#undef HB_WRITE
}


#define XB_TMO      128
#define XB_XCNT(j)  (256  + 64 * (j))
#define XB_XSUB(j)  (1280 + 64 * (j))
#define XB_XGEN(j)  (2304 + 64 * (j))
#define XB_TOP      3328
#define XB_TOPGEN   3392
#define XCD_BAR_WORDS 3456
#define XB_SPIN_CAP (1u << 18)
__device__ __forceinline__ unsigned xb_ld(unsigned* p)              { return __hip_atomic_load(p, __ATOMIC_RELAXED, __HIP_MEMORY_SCOPE_AGENT); }
__device__ __forceinline__ unsigned xb_add(unsigned* p, unsigned v) { return __hip_atomic_fetch_add(p, v, __ATOMIC_RELAXED, __HIP_MEMORY_SCOPE_AGENT); }
__device__ __forceinline__ unsigned xb_xcc_id() { return (unsigned)__builtin_amdgcn_s_getreg((3 << 11) | 20) & 0xFu; }
#define XB_SPIN(cond, bar) do { unsigned _sp = 0; while (cond) { __builtin_amdgcn_s_sleep(1); \
    if ((++_sp & 255u) == 0u) { if (xb_ld(&(bar)[XB_TMO])) break; if (_sp > XB_SPIN_CAP) { atomicAdd(&(bar)[XB_TMO], 1u); break; } } } } while (0)
__device__ __forceinline__ void xcd_barrier_complete(unsigned* bar, unsigned x, unsigned& nloc, unsigned& nx) {
    const unsigned G = gridDim.x * gridDim.y * gridDim.z;
    unsigned sum, cnt, mine, sp = 0u;
    for (;;) {
        sum = 0u; cnt = 0u; mine = 0u;
#pragma unroll
        for (unsigned j = 0; j < 16; ++j) { const unsigned c = xb_ld(&bar[XB_XCNT(j)]); sum += c; cnt += (c > 0u) ? 1u : 0u; mine = (j == x) ? c : mine; }
        if (sum == G) break;
        __builtin_amdgcn_s_sleep(1);
        if ((++sp & 255u) == 0u) { if (xb_ld(&bar[XB_TMO])) break; if (sp > XB_SPIN_CAP) { atomicAdd(&bar[XB_TMO], 1u); break; } }
    }
    nloc = mine > 0u ? mine : 1u; nx = cnt > 0u ? cnt : 1u;
}
__device__ __forceinline__ void xcd_barrier(unsigned* bar, volatile LAS unsigned* st, const bool t0) {
    asm volatile("s_waitcnt vmcnt(0)" ::: "memory");
    __syncthreads();
    if (t0) {
        const unsigned x = xb_xcc_id();
        __builtin_amdgcn_s_waitcnt(0);
        unsigned nloc = st[0], nx = st[1];
        if (nloc == 0u) { xcd_barrier_complete(bar, x, nloc, nx); st[0] = nloc; st[1] = nx; }
        const unsigned old = xb_add(&bar[XB_XSUB(x)], 1u);
        const unsigned gen = old / nloc;
        if (old + 1u == (gen + 1u) * nloc) {
            __builtin_amdgcn_fence(__ATOMIC_RELEASE, "agent");
            asm volatile("s_waitcnt vmcnt(0)" ::: "memory");
            const unsigned og = xb_add(&bar[XB_TOP], 1u);
            const unsigned tg = og / nx;
            if (og + 1u == (tg + 1u) * nx) xb_add(&bar[XB_TOPGEN], 1u);
            else XB_SPIN(xb_ld(&bar[XB_TOPGEN]) == tg, bar);
            __builtin_amdgcn_fence(__ATOMIC_ACQUIRE, "agent");
            xb_add(&bar[XB_XGEN(x)], 1u);
            asm volatile("s_waitcnt vmcnt(0)" ::: "memory");
        } else {
            XB_SPIN(xb_ld(&bar[XB_XGEN(x)]) == gen, bar);
            __builtin_amdgcn_fence(__ATOMIC_ACQUIRE, "agent");
            asm volatile("s_waitcnt vmcnt(0)" ::: "memory");
        }
    }
    __syncthreads();
}

struct Args { const float* in[22]; float* out; unsigned char* ws; int ph_lo, ph_hi; };

__global__ void __launch_bounds__(512, 2) mega(Args a) {
    extern __shared__ __attribute__((aligned(16))) unsigned char lds_raw[];
    LAS unsigned char* lds = (LAS unsigned char*)lds_raw;
    volatile LAS unsigned* MISC = (volatile LAS unsigned*)(lds + MISC_OFF);
    cg::grid_group grid = cg::this_grid();
    const int wave0 = __builtin_amdgcn_readfirstlane((int)threadIdx.x >> 6);
    if (threadIdx.x < 16) MISC[threadIdx.x] = 0u;
    __syncthreads();
    if (threadIdx.x == 0) (void)xb_add(&((unsigned*)(a.ws + WS_XBAR))[XB_XCNT(xb_xcc_id())], 1u);
    if (threadIdx.x == 0) {
        const float** tb = (const float**)(a.ws + WS_TBL);
        tb[0] = a.in[0]; tb[1] = a.in[1]; tb[2] = a.in[2]; tb[3] = a.in[3]; tb[4] = a.in[4]; tb[5] = a.in[5]; tb[6] = a.in[6]; tb[7] = a.in[7]; tb[8] = a.in[8]; tb[9] = a.in[9]; tb[10] = a.in[10];
        tb[11] = a.in[11]; tb[12] = a.in[12]; tb[13] = a.in[13]; tb[14] = a.in[14]; tb[15] = a.in[15]; tb[16] = a.in[16]; tb[17] = a.in[17]; tb[18] = a.in[18]; tb[19] = a.in[19]; tb[20] = a.in[20]; tb[21] = a.in[21];
        tb[22] = (const float*)a.out;
        __builtin_amdgcn_fence(__ATOMIC_RELEASE, "agent");
    }
    __syncthreads();
    __builtin_amdgcn_fence(__ATOMIC_ACQUIRE, "agent");
    for (int ph = a.ph_lo; ph < a.ph_hi; ++ph) {
#define TIDLANE const int tid = wave * 64 + fresh_lane(); const int lane = tid & 63; (void)lane; (void)tid
        __attribute__((address_space(1))) unsigned char* wsg = (__attribute__((address_space(1))) unsigned char*)a.ws; asm volatile("" : "+s"(wsg));
        unsigned char* ws = (unsigned char*)wsg;
        const float* const* tbl = (const float* const*)(ws + WS_TBL);
        float* out = (float*)uptr(tbl[22]);
        int wave = wave0; asm volatile("" : "+s"(wave));
        const int G = gridDim.x, bx = blockIdx.x;
        const int gw = bx * 8 + wave, NGW = G * 8;
        bf16_t* const AB = (bf16_t*)(ws + WS_AB);
        bf16_t* const R = (bf16_t*)(ws + WS_R);
        float* const STATS = (float*)(ws + WS_STATS);
        bf16_t* const MKV = (bf16_t*)(ws + WS_MKV);
        int kind, half = 0;
        if (ph < 3) kind = ph; else if (ph < 15) { const int sl = (ph - 3) % 6; half = (ph - 3) / 6; kind = sl == 0 ? 4 : (sl == 1 ? 13 : 3 + sl); } else kind = ph == 15 ? 10 : 11;
        bf16_t* const PROJ = R;
        const size_t hrow0 = (size_t)half * TH;
        if (kind == 0) {
            TIDLANE;
            LAS float* scr = (LAS float*)(lds + wave * 16384);
            constexpr int I_GU = 16 * 176, I_D = 44 * 32, I_IN = 16 * 320, I_SQ = 16 * 32, I_BR = 8 * 32;
            constexpr int NITEMS = 2 * I_GU + 2 * I_D + I_IN + 2 * I_SQ + 3 * I_BR;
            for (int it = gw; it < NITEMS; it += NGW) {
                int r = it;
                if (r < I_GU) { tr_weight(uptr(tbl[3]), 2 * DFF, uptr(tbl[2]), (bf16_t*)(ws + WS_WGU1), D, 2 * DFF, 1, r, scr, lane); continue; } r -= I_GU;
                if (r < I_GU) { tr_weight(uptr(tbl[19]), 2 * DFF, uptr(tbl[18]), (bf16_t*)(ws + WS_WGU2), D, 2 * DFF, 1, r, scr, lane); continue; } r -= I_GU;
                if (r < I_D) { tr_weight(uptr(tbl[4]), D, nullptr, (bf16_t*)(ws + WS_WD1), DFF, D, 0, r, scr, lane); continue; } r -= I_D;
                if (r < I_D) { tr_weight(uptr(tbl[20]), D, nullptr, (bf16_t*)(ws + WS_WD2), DFF, D, 0, r, scr, lane); continue; } r -= I_D;
                if (r < I_IN) { tr_weight(uptr(tbl[7]), DIN, uptr(tbl[6]), (bf16_t*)(ws + WS_WIN), D, DIN, 0, r, scr, lane); continue; } r -= I_IN;
                if (r < I_SQ) { tr_weight(uptr(tbl[12]), D, uptr(tbl[11]), (bf16_t*)(ws + WS_WMKV), D, D, 0, r, scr, lane); continue; } r -= I_SQ;
                if (r < I_SQ) { tr_weight(uptr(tbl[16]), D, nullptr, (bf16_t*)(ws + WS_WOUT), D, D, 0, r, scr, lane); continue; } r -= I_SQ;
                if (r < I_BR) { tr_weight(uptr(tbl[13]), D, nullptr, (bf16_t*)(ws + WS_WBR), 512, D, 0, r, scr, lane); continue; } r -= I_BR;
                if (r < I_BR) { tr_weight(uptr(tbl[14]), D, nullptr, (bf16_t*)(ws + WS_WBR + 1 * MiB), 512, D, 0, r, scr, lane); continue; } r -= I_BR;
                tr_weight(uptr(tbl[15]), D, nullptr, (bf16_t*)(ws + WS_WBR + 2 * MiB), 512, D, 0, r, scr, lane);
            }
            { const float* xin = uptr(tbl[0]);
            for (int m = gw; m < T; m += 2 * NGW) {
                const int m2 = m + NGW;
                row2_to_bf16_ss(xin + (size_t)m * D, xin + (size_t)m2 * D, AB + (size_t)m * D, AB + (size_t)m2 * D, (float*)(ws + WS_SS1) + m, (float*)(ws + WS_SS1) + m2, lane);
                if (lane < 2) { ((float*)(ws + WS_SS2))[lane * T + m] = 0.f; ((float*)(ws + WS_SS2))[lane * T + m2] = 0.f; }
                if (lane == 2) { if (m < 3 * 256 * 16) ((unsigned*)(ws + WS_CNT))[m] = 0u; if (m2 < 3 * 256 * 16) ((unsigned*)(ws + WS_CNT))[m2] = 0u; } } }
            for (int m = gw; m < NMEMROWS; m += NGW) row_to_bf16_rstd(uptr(tbl[1]) + (size_t)m * D, (bf16_t*)(ws + WS_MEMB) + (size_t)m * D, (float*)(ws + WS_RSTDM) + m, lane);
            if (bx == 0 && tid < 64) ((unsigned*)(ws + WS_CTR))[tid] = 0u;
        } else if (kind == 1 || kind == 10) {
            TIDLANE;
            pg8::Gemm g{AB, AB, AB, (const bf16_t*)(ws + (kind == 1 ? WS_WGU1 : WS_WGU2)), nullptr, nullptr, D, D, D};
            pg8::OrderT<1> S; S.init(T, 2 * DFF, G, bx);
            pg8::EpiSwiGLU E{R, (const float*)(ws + (kind == 1 ? WS_SS1 : WS_SS3))};
            pg8::gemm_phase<pg8::EpiSwiGLU, 1>(lds, g, S, E, wave);
        } else if (kind == 2 || kind == 11 || kind == 8) {
            TIDLANE;
            pg8::Gemm g; pg8::OrderT<1> S; pg8::EpiNormRes E;
            if (kind == 8) {
                g = pg8::Gemm{PROJ + C_YM, nullptr, nullptr, (const bf16_t*)(ws + WS_WOUT), nullptr, nullptr, PITCH, D, D};
                S.init(TH, D, G, bx);
                E = pg8::EpiNormRes{out, out, uptr(tbl[17]), ws, 1, (int)hrow0, half * 128};
            } else {
                g = pg8::Gemm{R, nullptr, nullptr, (const bf16_t*)(ws + (kind == 2 ? WS_WD1 : WS_WD2)), nullptr, nullptr, DFF, DFF, DFF};
                S.init(T, D, G, bx);
                if (kind == 2) E = pg8::EpiNormRes{uptr(tbl[0]), out, uptr(tbl[5]), ws, 0, 0, 0};
                else E = pg8::EpiNormRes{out, out, uptr(tbl[21]), ws, 2, 0, 0};
            }
            pg8::gemm_phase<pg8::EpiNormRes, 1>(lds, g, S, E, wave);
        } else if (kind == 4) {
            TIDLANE;
            for (int job = (half == 0 ? 0 : 1); job < 2; ++job) {
                pg8::Gemm g; pg8::OrderT<1> S; pg8::EpiProj E;
                if (job == 0) {
                    g = pg8::Gemm{(const bf16_t*)(ws + WS_MEMB), nullptr, nullptr, (const bf16_t*)(ws + WS_WMKV), nullptr, nullptr, D, D, D};
                    S.init(NMEMROWS, D, G, bx); E = pg8::EpiProj{MKV, D, (const float*)(ws + WS_RSTDM), uptr(tbl[8]), 1 << 20};
                } else {
                    g = pg8::Gemm{AB + hrow0 * D, nullptr, nullptr, (const bf16_t*)(ws + WS_WIN), nullptr, nullptr, D, D, D};
                    S.init(TH, DIN, G, bx); E = pg8::EpiProj{PROJ, PITCH, (const float*)(ws + WS_SS2) + hrow0, uptr(tbl[8]), C_GATE / 256};
                }
                pg8::gemm_phase<pg8::EpiProj, 1>(lds, g, S, E, wave);
            }
        } else if (kind == 5) {
            TIDLANE;
            unsigned* ctr = (unsigned*)(ws + WS_CTR) + half;
            constexpr int NHG = 32, NDIL = 3072, NMEMU = 1024, NTOT = NHG + NDIL + NMEMU;
            const float c_scale = 0.08838834764831845f * 1.4426950408889634f;
            if (tid == 0) MISC[0] = __hip_atomic_fetch_add(ctr, 1u, __ATOMIC_RELAXED, __HIP_MEMORY_SCOPE_AGENT);
            LDS_BAR();
            for (;;) {
                const int idx = (int)MISC[0];
                LDS_BAR();
                if (idx >= NTOT) break;
                unsigned nxt_idx = 0u;
                if (tid == 0) nxt_idx = __hip_atomic_fetch_add(ctr, 1u, __ATOMIC_RELAXED, __HIP_MEMORY_SCOPE_AGENT);
                if (idx < NHG) {
                    const int b = idx >> 2, hh = idx & 3; const size_t ch0 = (size_t)(b * 64) * 4 + hh;
                    hgB_unit(lds, PROJ + (size_t)b * SEQ * PITCH, hh, (const bf16_t*)(ws + WS_HGKT) + ch0 * 8192, (const bf16_t*)(ws + WS_HGVT) + ch0 * 8192,
                             (const bf16_t*)(ws + WS_HGSC) + ch0 * 4096, (const float*)(ws + WS_HGD) + ch0 * 128, tid);
                } else if (idx < NHG + NDIL) {
                    const int u = idx - NHG, b = u / 384, rem = u % 384, gi = rem >> 7, rem2 = rem & 127, hh = rem2 & 3, blk = rem2 >> 2;
                    const int dil = gi == 0 ? 1 : (gi == 1 ? 4 : 16), nb = 32 / dil, n = blk % nb, rr = blk / nb;
                    const ptrdiff_t tok0 = (ptrdiff_t)b * SEQ + (ptrdiff_t)n * 128 * dil + rr;
                    const bf16_t* q = PROJ + tok0 * PITCH + C_DIL + gi * 1536 + hh * 128;
                    const bf16_t* kp = PROJ + (tok0 - 128 * dil) * PITCH + C_DIL + gi * 1536 + 512 + hh * 128;
                    const float slope = exp2f(-8.0f * (float)(gi * 4 + hh + 1) / 12.0f);
                    attn_unit(lds, q, (size_t)dil * PITCH, kp, kp + 512, (size_t)dil * PITCH, n > 0 ? 1 : 0, 1, c_scale, slope * (float)dil * 1.4426950408889634f,
                              STATS + ((size_t)tok0 * 12 + gi * 4 + hh) * 2, (size_t)dil * 24, tid);
                } else {
                    const int u = idx - NHG - NDIL, b = u >> 7, rem = u & 127, hh = rem & 3, qb = rem >> 2;
                    const bf16_t* q = PROJ + ((size_t)b * SEQ + qb * 128) * PITCH + C_MQ + hh * 128;
                    const bf16_t* kp = MKV + (size_t)((half * 8 + b) * 256) * D + hh * 128;
                    attn_unit(lds, q, (size_t)PITCH, kp, kp + 512, (size_t)D, 1, 0, c_scale, 0.f, nullptr, 0, tid);
                }
                if (tid == 0) MISC[0] = nxt_idx;
                LDS_BAR();
            }
        } else if (kind == 13) {
            TIDLANE;
            HgRaw cur, nxt;
#pragma unroll
            for (int j = 0; j < 16; ++j) { cur.fr[j] = 0u; cur.qr[j] = 0u; cur.vr[j] = 0u; nxt.fr[j] = 0u; nxt.qr[j] = 0u; nxt.vr[j] = 0u; }
            if (bx < 2048) hgA_load(cur, PROJ + (size_t)(bx >> 2) * 64 * PITCH, bx & 3, tid);
            for (int u = bx; u < 2048; u += G) {
                const int hh = u & 3, bn = u >> 2, un = u + G;
                if (un < 2048) hgA_load(nxt, PROJ + (size_t)(un >> 2) * 64 * PITCH, un & 3, tid);
                hgA_unit(lds, cur, PROJ + (size_t)bn * 64 * PITCH, hh, uptr(tbl[9]), (bf16_t*)(ws + WS_HGKT) + (size_t)u * 8192, (bf16_t*)(ws + WS_HGVT) + (size_t)u * 8192,
                         (bf16_t*)(ws + WS_HGSC) + (size_t)u * 4096, (float*)(ws + WS_HGD) + (size_t)u * 128, tid);
                cur = nxt;
            }
        } else if (kind == 6) {
            TIDLANE;
            const float* hgw = uptr(tbl[10]);
            float wv[8];
#pragma unroll
            for (int j = 0; j < 8; ++j) wv[j] = hgw[(lane & 15) * 8 + j];
            const int hh = lane >> 4;
            for (int r0 = gw; r0 < TH; r0 += 2 * NGW) {
                bf16_t* prow[2]; u32x4 ow[2], gwd[2], d0[2], d1[2], d2[2]; float sm[2][6];
#pragma unroll
                for (int e = 0; e < 2; ++e) {
                    const int r = r0 + e * NGW; prow[e] = PROJ + (size_t)r * PITCH;
                    ow[e] = *(const u32x4*)(prow[e] + C_HI + lane * 8); gwd[e] = *(const u32x4*)(prow[e] + C_HOG + lane * 8);
                    d0[e] = *(const u32x4*)(prow[e] + C_DIL + lane * 8); d1[e] = *(const u32x4*)(prow[e] + C_DIL + 1536 + lane * 8); d2[e] = *(const u32x4*)(prow[e] + C_DIL + 3072 + lane * 8);
                    const float* st = STATS + ((size_t)r * 12 + hh) * 2;
                    sm[e][0] = st[0]; sm[e][1] = st[1]; sm[e][2] = st[8]; sm[e][3] = st[9]; sm[e][4] = st[16]; sm[e][5] = st[17];
                }
#pragma unroll
                for (int e = 0; e < 2; ++e) {
                    float o8[8] = {bflo(ow[e].x), bfhi(ow[e].x), bflo(ow[e].y), bfhi(ow[e].y), bflo(ow[e].z), bfhi(ow[e].z), bflo(ow[e].w), bfhi(ow[e].w)};
                    const float g8[8] = {bflo(gwd[e].x), bfhi(gwd[e].x), bflo(gwd[e].y), bfhi(gwd[e].y), bflo(gwd[e].z), bfhi(gwd[e].z), bflo(gwd[e].w), bfhi(gwd[e].w)};
                    float sq = 0.f;
#pragma unroll
                    for (int j = 0; j < 8; ++j) sq += o8[j] * o8[j];
                    sq += shfl_xor_f(sq, 1); sq += shfl_xor_f(sq, 2); sq += shfl_xor_f(sq, 4); sq += shfl_xor_f(sq, 8);
                    const float rs = 1.0f / sqrtf(sq * (1.0f / 128.0f) + EPS);
#pragma unroll
                    for (int j = 0; j < 8; ++j) o8[j] = o8[j] * rs * wv[j] * sigmoidf_(g8[j]);
                    u32x4 yw; yw.x = pk2(o8[0], o8[1]); yw.y = pk2(o8[2], o8[3]); yw.z = pk2(o8[4], o8[5]); yw.w = pk2(o8[6], o8[7]);
                    *(u32x4*)(prow[e] + C_HI + lane * 8) = yw;
                    const float m0 = sm[e][0], l0 = sm[e][1], m1 = sm[e][2], l1 = sm[e][3], m2 = sm[e][4], l2 = sm[e][5];
                    const float mm = fmaxf(m0, fmaxf(m1, m2));
                    float w0 = __builtin_amdgcn_exp2f(m0 - mm) * l0, w1 = __builtin_amdgcn_exp2f(m1 - mm) * l1, w2 = __builtin_amdgcn_exp2f(m2 - mm) * l2;
                    const float inv = 1.0f / (w0 + w1 + w2); w0 *= inv; w1 *= inv; w2 *= inv;
                    const u32x4 a0 = d0[e], a1 = d1[e], a2 = d2[e];
                    u32x4 dw;
                    dw.x = pk2(w0 * bflo(a0.x) + w1 * bflo(a1.x) + w2 * bflo(a2.x), w0 * bfhi(a0.x) + w1 * bfhi(a1.x) + w2 * bfhi(a2.x));
                    dw.y = pk2(w0 * bflo(a0.y) + w1 * bflo(a1.y) + w2 * bflo(a2.y), w0 * bfhi(a0.y) + w1 * bfhi(a1.y) + w2 * bfhi(a2.y));
                    dw.z = pk2(w0 * bflo(a0.z) + w1 * bflo(a1.z) + w2 * bflo(a2.z), w0 * bfhi(a0.z) + w1 * bfhi(a1.z) + w2 * bfhi(a2.z));
                    dw.w = pk2(w0 * bflo(a0.w) + w1 * bflo(a1.w) + w2 * bflo(a2.w), w0 * bfhi(a0.w) + w1 * bfhi(a1.w) + w2 * bfhi(a2.w));
                    *(u32x4*)(prow[e] + C_DIL + lane * 8) = dw;
                }
            }
        } else if (kind == 7) {
            TIDLANE;
            pg8::Gemm g{PROJ + C_HI, PROJ + C_DIL, PROJ + C_MQ, (const bf16_t*)(ws + WS_WBR), (const bf16_t*)(ws + WS_WBR + 1 * MiB), (const bf16_t*)(ws + WS_WBR + 2 * MiB), PITCH, 512, 512};
            pg8::OrderT<3> S; S.init(TH, D, G, bx);
            pg8::EpiMerge E{PROJ + C_GATE, PITCH, PROJ + C_YM, PITCH};
            pg8::gemm_phase<pg8::EpiMerge, 3>(lds, g, S, E, wave);
        }
        if (ph + 1 < a.ph_hi) {
            if (a.ph_hi > NPH) grid.sync();
            else xcd_barrier((unsigned*)(ws + WS_XBAR), MISC + 8, wave == 0 && fresh_lane() == 0);
        }
    }
}

extern "C" void kernel_launch(void* const* d_in, const int* in_sizes, int n_in, void* d_out, int out_size, void* d_ws, size_t ws_size, hipStream_t stream) {
    static int grid = 0;
    if (grid == 0) {
        if (n_in != 22 || out_size != T * D || ws_size < WS_END) { fprintf(stderr, "kernel_launch: unexpected shapes (n_in %d out %d ws %zu)\n", n_in, out_size, ws_size); grid = -1; return; }
        int dev = 0, cus = 0, per_cu = 0;
        hipGetDevice(&dev); hipDeviceGetAttribute(&cus, hipDeviceAttributeMultiprocessorCount, dev);
        hipFuncSetAttribute((const void*)mega, hipFuncAttributeMaxDynamicSharedMemorySize, LDS_BYTES);
        hipOccupancyMaxActiveBlocksPerMultiprocessor(&per_cu, (const void*)mega, 512, LDS_BYTES);
        if (per_cu < 1) { fprintf(stderr, "kernel_launch: occupancy query says %d blocks/CU\n", per_cu); per_cu = 1; }
        grid = cus * per_cu;
        while (grid > 1 && ((TH % (16 * grid)) != 0)) --grid;
        (void)hipGetLastError();
    }
    if (grid < 0) return;
    (void)hipMemsetAsync((char*)d_ws + WS_XBAR, 0, 16384, stream);
    Args a{};
    for (int i = 0; i < 22; ++i) a.in[i] = (const float*)d_in[i];
    a.out = (float*)d_out; a.ws = (unsigned char*)d_ws;
#if MK_MULTI
    for (int ph = 0; ph < NPH; ++ph) { a.ph_lo = ph; a.ph_hi = ph + 1; hipLaunchKernelGGL(mega, dim3(grid), dim3(512), LDS_BYTES, stream, a); }
#else
    a.ph_lo = 0; a.ph_hi = NPH;
    void* args[] = {&a};
    hipError_t e = hipLaunchCooperativeKernel((const void*)mega, dim3(grid), dim3(512), args, LDS_BYTES, stream);
    if (e != hipSuccess) fprintf(stderr, "cooperative launch failed: %s (grid %d)\n", hipGetErrorString(e), grid);
#endif
}
```

```cpp
#include <hip/hip_runtime.h>
#include <hip/hip_cooperative_groups.h>
#include <cstdio>
#include <cstdint>
namespace cg = cooperative_groups;

#ifndef MK_MULTI
#define MK_MULTI 0
#endif

#define LAS __attribute__((address_space(3)))
typedef unsigned short bf16_t;
typedef short bf16x8 __attribute__((ext_vector_type(8)));
typedef float f32x4 __attribute__((ext_vector_type(4)));
typedef float f32x16 __attribute__((ext_vector_type(16)));
typedef unsigned u32x4 __attribute__((ext_vector_type(4)));
typedef unsigned u32x2 __attribute__((ext_vector_type(2)));

constexpr int T = 65536, TH = 32768, SEQ = 4096, D = 1024, DFF = 2816, DIN = 10240, PITCH = 10240, NMEMROWS = 4096;
constexpr int C_HQ = 0, C_HF = 512, C_HI = 1024, C_HOG = 1536, C_DIL = 2048, C_MQ = 6656, C_GATE = 7168, C_YM = 4096, C_YMIX = 5632;
constexpr float EPS = 1e-6f;
constexpr size_t MiB = 1u << 20, KiB = 1u << 10;
constexpr size_t WS_CTR = 0, WS_TBL = 2 * KiB  , WS_CNT = 4 * KiB  , WS_SS1 = 64 * KiB, WS_SS2 = 320 * KiB, WS_SS3 = 576 * KiB, WS_RSTDM = 832 * KiB;
constexpr size_t WS_STATS = 1 * MiB, WS_XBAR = 4 * MiB  ;
constexpr size_t WS_WGU1 = 5 * MiB, WS_WD1 = 16 * MiB, WS_WIN = WS_WD1 + 5632 * KiB, WS_WMKV = WS_WIN + 20 * MiB, WS_WBR = WS_WMKV + 2 * MiB,
                 WS_WOUT = WS_WBR + 3 * MiB, WS_WGU2 = WS_WOUT + 2 * MiB, WS_WD2 = WS_WGU2 + 11 * MiB;
constexpr size_t WS_MEMB = 65 * MiB, WS_MKV = 73 * MiB, WS_AB = 81 * MiB, WS_R = 209 * MiB, WS_Y1 = WS_R + 352 * MiB, WS_HGKT = WS_R + 640 * MiB, WS_HGVT = WS_HGKT + 32 * MiB, WS_HGSC = WS_HGVT + 32 * MiB, WS_HGD = WS_HGSC + 16 * MiB, WS_END = WS_HGD + 1 * MiB;
static_assert(WS_WD2 + 5632 * KiB <= WS_MEMB, "weights");
constexpr int LDS_BYTES = 140 * 1024, MISC_OFF = 139264;
constexpr int NPH = 17;

__device__ __forceinline__ unsigned f2bf(float f);
typedef float f32x2_t __attribute__((ext_vector_type(2)));
typedef __bf16 bf16x2_t __attribute__((ext_vector_type(2)));
__device__ __forceinline__ unsigned pk2(float lo, float hi) { const f32x2_t v = {lo, hi}; return __builtin_bit_cast(unsigned, __builtin_convertvector(v, bf16x2_t)); }
__device__ __forceinline__ float bflo(unsigned w) { return __builtin_bit_cast(float, w << 16); }
__device__ __forceinline__ float bfhi(unsigned w) { return __builtin_bit_cast(float, w & 0xffff0000u); }
__device__ __forceinline__ float bf2f(bf16_t b) { return __builtin_bit_cast(float, ((unsigned)b) << 16); }
__device__ __forceinline__ float sigmoidf_(float x) { return __builtin_amdgcn_rcpf(1.0f + __expf(-x)); }
__device__ __forceinline__ const float* uptr(const float* p) {
    const unsigned long long v = (unsigned long long)p; const unsigned lo = __builtin_amdgcn_readfirstlane((unsigned)v), hi = __builtin_amdgcn_readfirstlane((unsigned)(v >> 32));
    return (const float*)(__attribute__((address_space(1))) const float*)(((unsigned long long)hi << 32) | lo); }
__device__ __forceinline__ int fresh_lane() { int z = 0; asm volatile("" : "+v"(z)); return (int)__builtin_amdgcn_mbcnt_hi(~0u, __builtin_amdgcn_mbcnt_lo(~0u, (unsigned)z)); }
__device__ __forceinline__ float shfl_xor_f(float v, int o) { const int l = fresh_lane(); return __builtin_bit_cast(float, __builtin_amdgcn_ds_bpermute((l ^ o) << 2, __builtin_bit_cast(int, v))); }
__device__ __forceinline__ float wave_sum(float v) {
    const int l = fresh_lane();
#pragma unroll
    for (int o = 1; o < 64; o <<= 1) v += __builtin_bit_cast(float, __builtin_amdgcn_ds_bpermute((l ^ o) << 2, __builtin_bit_cast(int, v)));
    return v;
}
__device__ __forceinline__ unsigned cvt_pk_bf16(float lo, float hi) { return pk2(lo, hi); }
__device__ __forceinline__ unsigned f2bf(float f) { return pk2(f, 0.f) & 0xffffu; }

namespace pg8 {
constexpr int BM = 256, BK = 64, HALF = 128, HTB = HALF * BK * 2, NXCD = 8, WGM = 8;
__device__ __forceinline__ int lds_byte(int r, int c) { const int st = (r >> 4) * 2 + (c >> 5), rr = r & 15, cc = c & 31, ob = rr * 64 + cc * 2; return st * 1024 + (ob ^ (((ob >> 9) & 1) << 5)); }
__device__ __forceinline__ void stage_rc(int b, int& R, int& C) { const int st = b / 1024, sb = b % 1024, swz = sb ^ (((sb >> 9) & 1) << 5); R = (st >> 1) * 16 + swz / 64; C = (st & 1) * 32 + (swz % 64) / 2; }
__device__ __forceinline__ int perm32(int rho) { const int n = rho >> 4, i = rho & 15; return 8 * (i >> 2) + 4 * n + (i & 3); }

struct Unit { int pm, pn, seg; };
struct Gemm { const bf16_t* A0; const bf16_t* A1; const bf16_t* A2; const bf16_t* B0; const bf16_t* B1; const bf16_t* B2; int lda, ldb, K; };

template <int NSEG> struct OrderT {
    int nM, nN, nwg, G, c;
    __device__ void init(int M, int N, int G_, int c_) { nM = M / BM; nN = N / BM; nwg = nM * nN; G = G_; c = c_; }
    __device__ bool next(int i, Unit& u) const {
        const int rnd = i / NSEG; u.seg = i - rnd * NSEG;
        const long L = (long)rnd * G + c; if (L >= nwg) return false;
        int wgid = (int)L; { const int q = nwg / NXCD, r = nwg % NXCD, xcd = wgid % NXCD, off = wgid / NXCD; wgid = (xcd < r ? xcd * (q + 1) : r * (q + 1) + (xcd - r) * q) + off; }
        const int nig = WGM * nN, gid = wgid / nig, fm = gid * WGM, gsz = (nM - fm) < WGM ? (nM - fm) : WGM;
        u.pm = fm + ((wgid % nig) % gsz); u.pn = (wgid % nig) / gsz; return true;
    }
};

#define ZERO_ACC() do { _Pragma("unroll") for (int a_ = 0; a_ < 2; ++a_) _Pragma("unroll") for (int b_ = 0; b_ < 2; ++b_) _Pragma("unroll") for (int m_ = 0; m_ < 4; ++m_) _Pragma("unroll") for (int n_ = 0; n_ < 2; ++n_) acc[a_][b_][m_][n_] = (f32x4){0.f, 0.f, 0.f, 0.f}; } while (0)

struct EpiSwiGLU {
    bf16_t* H; const float* rstd;
    __device__ __forceinline__ void operator()(f32x4 (&acc)[2][2][4][2], const Unit& u, int wr, int wc, int fr, int fq, LAS unsigned char* lds, int wid, int lane) const {
        const int row0 = u.pm * BM + wr * 64 + fr, col0 = u.pn * 128 + wc * 32 + 8 * fq;
        float ssv[2][4];
#pragma unroll
        for (int ai = 0; ai < 2; ++ai)
#pragma unroll
            for (int m = 0; m < 4; ++m) ssv[ai][m] = rstd[row0 + ai * HALF + m * 16];
#pragma unroll
        for (int ai = 0; ai < 2; ++ai)
#pragma unroll
            for (int m = 0; m < 4; ++m) {
                const int row = row0 + ai * HALF + m * 16; const float rs = __builtin_amdgcn_rsqf(ssv[ai][m] * (1.0f / D) + EPS);
                float hv[8];
#pragma unroll
                for (int n = 0; n < 2; ++n)
#pragma unroll
                    for (int j = 0; j < 4; ++j) { const float g = acc[ai][0][m][n][j] * rs, uu = acc[ai][1][m][n][j] * rs; hv[n * 4 + j] = g * sigmoidf_(g) * uu; }
                u32x4 w; w.x = cvt_pk_bf16(hv[0], hv[1]); w.y = cvt_pk_bf16(hv[2], hv[3]); w.z = cvt_pk_bf16(hv[4], hv[5]); w.w = cvt_pk_bf16(hv[6], hv[7]);
                *(u32x4*)(H + (size_t)row * DFF + col0) = w;
            }
        ZERO_ACC();
    }
};
struct EpiProj {
    bf16_t* P; int ldp; const float* rstd; const float* bgate; int gate_pn0;
    __device__ __forceinline__ void operator()(f32x4 (&acc)[2][2][4][2], const Unit& u, int wr, int wc, int fr, int fq, LAS unsigned char* lds, int wid, int lane) const {
        const int row0 = u.pm * BM + wr * 64 + fr, col0 = u.pn * BM + wc * 32 + 8 * fq; const bool gate = u.pn >= gate_pn0;
        f32x4 bv[2][2];
#pragma unroll
        for (int bj = 0; bj < 2; ++bj)
#pragma unroll
            for (int n = 0; n < 2; ++n) bv[bj][n] = gate ? *(const f32x4*)(bgate + (col0 - gate_pn0 * BM) + bj * HALF + 4 * n) : (f32x4){0.f, 0.f, 0.f, 0.f};
        float ssv[2][4];
#pragma unroll
        for (int ai = 0; ai < 2; ++ai)
#pragma unroll
            for (int m = 0; m < 4; ++m) ssv[ai][m] = rstd[row0 + ai * HALF + m * 16];
#pragma unroll
        for (int ai = 0; ai < 2; ++ai)
#pragma unroll
            for (int m = 0; m < 4; ++m) {
                const int row = row0 + ai * HALF + m * 16; const float rs = __builtin_amdgcn_rsqf(ssv[ai][m] * (1.0f / D) + EPS);
#pragma unroll
                for (int bj = 0; bj < 2; ++bj) {
                    f32x4 v0 = acc[ai][bj][m][0] * rs, v1 = acc[ai][bj][m][1] * rs;
                    if (gate) {
                        v0 = v0 + bv[bj][0]; v1 = v1 + bv[bj][1];
#pragma unroll
                        for (int j = 0; j < 4; ++j) { v0[j] = sigmoidf_(v0[j]); v1[j] = sigmoidf_(v1[j]); }
                    }
                    u32x4 w; w.x = cvt_pk_bf16(v0[0], v0[1]); w.y = cvt_pk_bf16(v0[2], v0[3]); w.z = cvt_pk_bf16(v1[0], v1[1]); w.w = cvt_pk_bf16(v1[2], v1[3]);
                    *(u32x4*)(P + (size_t)row * ldp + col0 + bj * HALF) = w;
                }
            }
        ZERO_ACC();
    }
};
constexpr int EPI_P_OFF = 131072, EPI_S_OFF = EPI_P_OFF + 4096;
struct EpiNormRes {
    const float* hprev; float* hout; const float* postw; unsigned char* wsb; int bank, rowbase, pmbase;
    __device__ __forceinline__ void operator()(f32x4 (&acc)[2][2][4][2], const Unit& u, int wr, int wc, int fr_, int fq_, LAS unsigned char* lds, int wid, int lane_) const {
        const int lane = fresh_lane(), fr = lane & 15, fq = lane >> 4; (void)fr_; (void)fq_; (void)lane_;
        LAS float* P = (LAS float*)(lds + EPI_P_OFF); LAS float* S = (LAS float*)(lds + EPI_S_OFF);
        const int pmg = pmbase + u.pm;
        float* const xbuf = (float*)(wsb + WS_STATS) + (size_t)bank * 262144; unsigned* const cnt = (unsigned*)(wsb + WS_CNT) + bank * 4096;
        bf16_t* const hb = bank < 2 ? (bf16_t*)(wsb + WS_AB) : nullptr; float* const ssn = bank == 0 ? (float*)(wsb + WS_SS2) : (bank == 1 ? (float*)(wsb + WS_SS3) : nullptr);
        const float scale = bank == 1 ? 1.0f : 0.5f;
        const int col0 = u.pn * BM + wc * 32 + 8 * fq;
        u32x2 yp[2][2][4][2];
#pragma unroll
        for (int ai = 0; ai < 2; ++ai)
#pragma unroll
            for (int m = 0; m < 4; ++m) {
                float q = 0.f;
#pragma unroll
                for (int bj = 0; bj < 2; ++bj)
#pragma unroll
                    for (int n = 0; n < 2; ++n) { const f32x4 v = acc[ai][bj][m][n]; q += (v[0] * v[0] + v[1] * v[1]) + (v[2] * v[2] + v[3] * v[3]);
                        yp[ai][bj][m][n] = (u32x2){pk2(v[0], v[1]), pk2(v[2], v[3])}; }
                q += shfl_xor_f(q, 16); q += shfl_xor_f(q, 32);
                if (fq == 0) P[(ai * HALF + wr * 64 + m * 16 + fr) * 4 + wc] = q;
            }
        f32x4 hp[4][2][2];
#pragma unroll
        for (int m = 0; m < 4; ++m) { const size_t off = (size_t)(rowbase + u.pm * BM + wr * 64 + m * 16 + fr) * D + col0;
#pragma unroll
            for (int bj = 0; bj < 2; ++bj) { hp[m][bj][0] = *(const f32x4*)(hprev + off + bj * HALF); hp[m][bj][1] = *(const f32x4*)(hprev + off + bj * HALF + 4); } }
        asm volatile("s_waitcnt lgkmcnt(0)" ::: "memory"); __builtin_amdgcn_s_barrier(); asm volatile("" ::: "memory");
        const int prow = wid * 32 + (lane & 31);
        float* slot = xbuf + ((size_t)pmg * 256 + prow) * 4;
        if (lane < 32) { const f32x4 pp = *(const LAS f32x4*)(P + prow * 4); __hip_atomic_store(slot + u.pn, (pp[0] + pp[1]) + (pp[2] + pp[3]), __ATOMIC_RELAXED, __HIP_MEMORY_SCOPE_AGENT); }
        asm volatile("s_waitcnt vmcnt(0)" ::: "memory");
        if (lane == 0) __hip_atomic_fetch_add(cnt + pmg * 16, 1u, __ATOMIC_RELAXED, __HIP_MEMORY_SCOPE_AGENT);
        if (wid == 0) {
            unsigned spins = 0;
            while ((unsigned)__builtin_amdgcn_readfirstlane((int)__hip_atomic_load(cnt + pmg * 16, __ATOMIC_RELAXED, __HIP_MEMORY_SCOPE_AGENT)) < 32u) { __builtin_amdgcn_s_sleep(2); if (++spins > (1u << 22)) break; }
            __builtin_amdgcn_fence(__ATOMIC_ACQUIRE, "agent");
            asm volatile("s_waitcnt vmcnt(0)" ::: "memory");
        }
        asm volatile("" ::: "memory"); __builtin_amdgcn_s_barrier(); asm volatile("" ::: "memory");
        if (lane < 32) {
            const float s0 = __hip_atomic_load(slot + 0, __ATOMIC_RELAXED, __HIP_MEMORY_SCOPE_AGENT), s1 = __hip_atomic_load(slot + 1, __ATOMIC_RELAXED, __HIP_MEMORY_SCOPE_AGENT),
                        s2 = __hip_atomic_load(slot + 2, __ATOMIC_RELAXED, __HIP_MEMORY_SCOPE_AGENT), s3 = __hip_atomic_load(slot + 3, __ATOMIC_RELAXED, __HIP_MEMORY_SCOPE_AGENT);
            S[prow] = __builtin_amdgcn_rsqf(((s0 + s1) + (s2 + s3)) * (1.0f / D) + EPS);
        }
        asm volatile("s_waitcnt vmcnt(0) lgkmcnt(0)" ::: "memory"); __builtin_amdgcn_s_barrier(); asm volatile("" ::: "memory");
        f32x4 pw[2][2];
#pragma unroll
        for (int bj = 0; bj < 2; ++bj)
#pragma unroll
            for (int n = 0; n < 2; ++n) pw[bj][n] = *(const f32x4*)(postw + col0 + bj * HALF + 4 * n) * scale;
#pragma unroll
        for (int ai = 0; ai < 2; ++ai) {
            if (ai == 1) {
#pragma unroll
                for (int m = 0; m < 4; ++m) { const size_t off = (size_t)(rowbase + u.pm * BM + HALF + wr * 64 + m * 16 + fr) * D + col0;
#pragma unroll
                    for (int bj = 0; bj < 2; ++bj) { hp[m][bj][0] = *(const f32x4*)(hprev + off + bj * HALF); hp[m][bj][1] = *(const f32x4*)(hprev + off + bj * HALF + 4); } }
            }
#pragma unroll
            for (int m = 0; m < 4; ++m) {
                const int rl = ai * HALF + wr * 64 + m * 16 + fr; const float rs = S[rl];
                const size_t off = (size_t)(rowbase + u.pm * BM + rl) * D + col0; float q2 = 0.f;
#pragma unroll
                for (int bj = 0; bj < 2; ++bj) {
                    const u32x2 y0 = yp[ai][bj][m][0], y1 = yp[ai][bj][m][1];
                    const f32x4 ya = (f32x4){bflo(y0.x), bfhi(y0.x), bflo(y0.y), bfhi(y0.y)}, yb = (f32x4){bflo(y1.x), bfhi(y1.x), bflo(y1.y), bfhi(y1.y)};
                    const f32x4 h0 = hp[m][bj][0] + pw[bj][0] * (ya * rs);
                    const f32x4 h1 = hp[m][bj][1] + pw[bj][1] * (yb * rs);
                    *(f32x4*)(hout + off + bj * HALF) = h0; *(f32x4*)(hout + off + bj * HALF + 4) = h1;
                    if (hb) { u32x4 w; w.x = pk2(h0[0], h0[1]); w.y = pk2(h0[2], h0[3]); w.z = pk2(h1[0], h1[1]); w.w = pk2(h1[2], h1[3]); *(u32x4*)(hb + off + bj * HALF) = w; }
                    q2 += (h0[0] * h0[0] + h0[1] * h0[1]) + (h0[2] * h0[2] + h0[3] * h0[3]) + (h1[0] * h1[0] + h1[1] * h1[1]) + (h1[2] * h1[2] + h1[3] * h1[3]);
                }
                if (ssn) { q2 += shfl_xor_f(q2, 16); q2 += shfl_xor_f(q2, 32); if (fq == 0) atomicAdd(ssn + rowbase + u.pm * BM + rl, q2); }
            }
        }
        ZERO_ACC();
    }
};
struct EpiMerge {
    const bf16_t* G; int ldg; bf16_t* YM; int ldy;
    __device__ __forceinline__ void operator()(f32x4 (&acc)[2][2][4][2], const Unit& u, int wr, int wc, int fr, int fq, LAS unsigned char* lds, int wid, int lane) const {
        const int row0 = u.pm * BM + wr * 64 + fr, col0 = u.pn * BM + wc * 32 + 8 * fq; const int seg = u.seg;
#pragma unroll
        for (int ai = 0; ai < 2; ++ai) {
            u32x4 gcv[4][2], gnv[4][2];
#pragma unroll
            for (int m = 0; m < 4; ++m)
#pragma unroll
                for (int bj = 0; bj < 2; ++bj) {
                    const bf16_t* gp = G + (size_t)(row0 + ai * HALF + m * 16) * ldg + seg * D + col0 + bj * HALF;
                    gcv[m][bj] = *(const u32x4*)gp; gnv[m][bj] = (u32x4){0u, 0u, 0u, 0u};
                    if (seg < 2) gnv[m][bj] = *(const u32x4*)(gp + D);
                }
#pragma unroll
            for (int m = 0; m < 4; ++m) {
                const int row = row0 + ai * HALF + m * 16;
#pragma unroll
                for (int bj = 0; bj < 2; ++bj) {
                    const u32x4 gc = gcv[m][bj];
                    float f[8] = {bflo(gc.x), bfhi(gc.x), bflo(gc.y), bfhi(gc.y), bflo(gc.z), bfhi(gc.z), bflo(gc.w), bfhi(gc.w)};
                    if (seg < 2) {
                        const u32x4 gn = gnv[m][bj];
                        const float d[8] = {bflo(gn.x), bfhi(gn.x), bflo(gn.y), bfhi(gn.y), bflo(gn.z), bfhi(gn.z), bflo(gn.w), bfhi(gn.w)};
#pragma unroll
                        for (int j = 0; j < 8; ++j) f[j] = f[j] * __builtin_amdgcn_rcpf(d[j]);
                    }
                    f32x4 v0 = acc[ai][bj][m][0], v1 = acc[ai][bj][m][1];
#pragma unroll
                    for (int j = 0; j < 4; ++j) { v0[j] *= f[j]; v1[j] *= f[4 + j]; }
                    if (seg == 2) {
                        u32x4 w; w.x = cvt_pk_bf16(v0[0], v0[1]); w.y = cvt_pk_bf16(v0[2], v0[3]); w.z = cvt_pk_bf16(v1[0], v1[1]); w.w = cvt_pk_bf16(v1[2], v1[3]);
                        *(u32x4*)(YM + (size_t)row * ldy + col0 + bj * HALF) = w;
                        v0 = (f32x4){0.f, 0.f, 0.f, 0.f}; v1 = v0;
                    }
                    acc[ai][bj][m][0] = v0; acc[ai][bj][m][1] = v1;
                }
            }
        }
    }
};

#ifndef PG8_SP2
#define PG8_SP2 1
#endif
template <class Epi, int NSEG>
__device__ __forceinline__ void gemm_phase(LAS unsigned char* lds, const Gemm g, const OrderT<NSEG>& S, const Epi& E, const int wid) {
    const int lane = fresh_lane(), tid = wid * 64 + lane, wr = wid >> 2, wc = wid & 3, fr = lane & 15, fq = lane >> 4;
    const int K = g.K, nt = K / BK;
    unsigned voffA[2], voffB[2];
#pragma unroll
    for (int i = 0; i < 2; ++i) { int R, C; stage_rc(tid * 16 + i * 8192, R, C); const int Rb = (R & ~31) + perm32(R & 31);
        voffA[i] = (unsigned)(R * g.lda + C) * 2u; voffB[i] = (unsigned)(Rb * g.ldb + C) * 2u; }
    const size_t kstep = (size_t)(BK * 2);
    const size_t hstepA = (size_t)HALF * g.lda * 2, hstepB = (size_t)HALF * g.ldb * 2;
    const size_t tstepA = 2 * hstepA, tstepB = 2 * hstepB;
    const unsigned ldsw = (unsigned)wid * 1024u;
    const int aoff = lds_byte(wr * 64 + fr, fq * 8), boff = lds_byte(wc * 32 + fr, fq * 8);
#define PG8_SA(b, h) (((b) * 2 + (h)) * HTB)
#define PG8_SB(b, h) ((4 + (b) * 2 + (h)) * HTB)
#define PG8_STAGE(bufoff, gbase, voff) do { _Pragma("unroll") for (int _i = 0; _i < 2; ++_i) \
        __builtin_amdgcn_global_load_lds((const unsigned*)((const char*)(gbase) + (voff)[_i]), (LAS unsigned*)(lds + (bufoff) + ldsw + _i * 8192), 16, 0, 0); } while (0)
#define PG8_LDA(dst, b, h) do { _Pragma("unroll") for (int m = 0; m < 4; ++m) _Pragma("unroll") for (int k = 0; k < 2; ++k) dst[m][k] = *(const LAS bf16x8*)(lds + PG8_SA(b, h) + aoff + m * 2048 + k * 1024); } while (0)
#define PG8_LDB(dst, b, h) do { _Pragma("unroll") for (int n = 0; n < 2; ++n) _Pragma("unroll") for (int k = 0; k < 2; ++k) dst[n][k] = *(const LAS bf16x8*)(lds + PG8_SB(b, h) + boff + n * 2048 + k * 1024); } while (0)
#define PG8_MMA(ai, bj, At, Bt) do { __builtin_amdgcn_s_setprio(1); _Pragma("unroll") for (int m = 0; m < 4; ++m) _Pragma("unroll") for (int n = 0; n < 2; ++n) _Pragma("unroll") for (int k = 0; k < 2; ++k) \
        acc[ai][bj][m][n] = __builtin_amdgcn_mfma_f32_16x16x32_bf16(Bt[n][k], At[m][k], acc[ai][bj][m][n], 0, 0, 0); __builtin_amdgcn_s_setprio(0); } while (0)
#define PG8_WAIT_V(n) asm volatile("s_waitcnt vmcnt(" #n ")" ::: "memory")
#define PG8_WAIT_L(n) asm volatile("s_waitcnt lgkmcnt(" #n ")" ::: "memory")
#define PG8_BAR __builtin_amdgcn_s_barrier()
#define PG8_SCHED __builtin_amdgcn_sched_barrier(0)
#define PG8_APTR(u) ((const char*)((NSEG == 1 || (u).seg == 0) ? g.A0 : ((u).seg == 1 ? g.A1 : g.A2)) + (size_t)(u).pm * tstepA)
#define PG8_BPTR(u) ((const char*)((NSEG == 1 || (u).seg == 0) ? g.B0 : ((u).seg == 1 ? g.B1 : g.B2)) + (size_t)(u).pn * tstepB)
    Unit cur, nxt; int ui = 0;
    if (!S.next(0, cur)) return;
    f32x4 acc[2][2][4][2];
    ZERO_ACC();
    bf16x8 At[4][2], B0[2][2], B1[2][2];
    const char* cA = PG8_APTR(cur); const char* cB = PG8_BPTR(cur);
    if constexpr (PG8_SP2) {
    PG8_STAGE(PG8_SB(0, 0), cB, voffB); PG8_STAGE(PG8_SB(0, 1), cB + hstepB, voffB); PG8_STAGE(PG8_SA(0, 0), cA, voffA); PG8_STAGE(PG8_SA(0, 1), cA + hstepA, voffA);
    if (wr == 1) PG8_BAR;
    PG8_WAIT_V(2); PG8_BAR;
    PG8_STAGE(PG8_SB(1, 0), cB + kstep, voffB); PG8_STAGE(PG8_SA(1, 0), cA + kstep, voffA); PG8_STAGE(PG8_SB(1, 1), cB + hstepB + kstep, voffB);
    PG8_WAIT_V(6); PG8_BAR;
    } else {
    PG8_STAGE(PG8_SB(0, 0), cB, voffB); PG8_STAGE(PG8_SA(0, 0), cA, voffA); PG8_STAGE(PG8_SB(0, 1), cB + hstepB, voffB); PG8_STAGE(PG8_SA(0, 1), cA + hstepA, voffA);
    if (wr == 1) PG8_BAR;
    PG8_WAIT_V(4); PG8_BAR;
    PG8_STAGE(PG8_SB(1, 0), cB + kstep, voffB); PG8_STAGE(PG8_SA(1, 0), cA + kstep, voffA); PG8_STAGE(PG8_SB(1, 1), cB + hstepB + kstep, voffB);
    PG8_WAIT_V(6); PG8_BAR;
    }
    for (;;) {
        const bool has_next = S.next(ui + 1, nxt);
        const char* nA = has_next ? PG8_APTR(nxt) : cA; const char* nB = has_next ? PG8_BPTR(nxt) : cB;
        for (int t = 0; t < nt; t += 2) {
            const bool last = (t == nt - 2);
            const char* a1 = cA + (size_t)(t + 1) * kstep;
            const char* a2 = last ? nA : cA + (size_t)(t + 2) * kstep; const char* b2 = last ? nB : cB + (size_t)(t + 2) * kstep;
            const char* a3 = a2 + kstep; const char* b3 = b2 + kstep;
            if constexpr (!PG8_SP2) {
            PG8_LDB(B0, 0, 0); PG8_SCHED; PG8_LDA(At, 0, 0); PG8_STAGE(PG8_SA(1, 1), a1 + hstepA, voffA);
            PG8_WAIT_L(8); PG8_BAR; PG8_WAIT_L(0); PG8_MMA(0, 0, At, B0); PG8_BAR; PG8_SCHED;
            PG8_LDB(B1, 0, 1); PG8_STAGE(PG8_SB(0, 0), b2, voffB);
            PG8_BAR; PG8_WAIT_L(0); PG8_MMA(0, 1, At, B1); PG8_BAR;
            PG8_LDA(At, 0, 1); PG8_STAGE(PG8_SA(0, 0), a2, voffA);
            PG8_BAR; PG8_WAIT_L(0); PG8_MMA(1, 0, At, B0); PG8_BAR; PG8_SCHED;
            PG8_STAGE(PG8_SB(0, 1), b2 + hstepB, voffB);
            PG8_WAIT_V(6); PG8_BAR; PG8_MMA(1, 1, At, B1); PG8_BAR;
            PG8_LDB(B0, 1, 0); PG8_SCHED; PG8_LDA(At, 1, 0); PG8_STAGE(PG8_SA(0, 1), a2 + hstepA, voffA);
            PG8_WAIT_L(8); PG8_BAR; PG8_WAIT_L(0); PG8_MMA(0, 0, At, B0); PG8_BAR; PG8_SCHED;
            PG8_LDB(B1, 1, 1); PG8_STAGE(PG8_SB(1, 0), b3, voffB);
            PG8_BAR; PG8_WAIT_L(0); PG8_MMA(0, 1, At, B1); PG8_BAR;
            PG8_LDA(At, 1, 1); PG8_STAGE(PG8_SA(1, 0), a3, voffA);
            PG8_BAR; PG8_WAIT_L(0); PG8_MMA(1, 0, At, B0); PG8_BAR; PG8_SCHED;
            PG8_STAGE(PG8_SB(1, 1), b3 + hstepB, voffB);
            PG8_WAIT_V(6); PG8_BAR; PG8_MMA(1, 1, At, B1); PG8_BAR;
            } else {
            PG8_LDB(B0, 0, 0); PG8_LDB(B1, 0, 1); PG8_SCHED; PG8_LDA(At, 0, 0); PG8_STAGE(PG8_SA(1, 1), a1 + hstepA, voffA);
            PG8_WAIT_V(8); PG8_WAIT_L(0); PG8_BAR; PG8_MMA(0, 0, At, B0); PG8_MMA(0, 1, At, B1); PG8_BAR; PG8_SCHED;
            PG8_LDA(At, 0, 1); PG8_STAGE(PG8_SB(0, 0), b2, voffB); PG8_STAGE(PG8_SB(0, 1), b2 + hstepB, voffB); PG8_STAGE(PG8_SA(0, 0), a2, voffA);
            PG8_WAIT_V(8); PG8_WAIT_L(0); PG8_BAR; PG8_MMA(1, 0, At, B0); PG8_MMA(1, 1, At, B1); PG8_BAR; PG8_SCHED;
            PG8_LDB(B0, 1, 0); PG8_LDB(B1, 1, 1); PG8_SCHED; PG8_LDA(At, 1, 0); PG8_STAGE(PG8_SA(0, 1), a2 + hstepA, voffA);
            PG8_WAIT_V(8); PG8_WAIT_L(0); PG8_BAR; PG8_MMA(0, 0, At, B0); PG8_MMA(0, 1, At, B1); PG8_BAR; PG8_SCHED;
            PG8_LDA(At, 1, 1); PG8_STAGE(PG8_SB(1, 0), b3, voffB); PG8_STAGE(PG8_SB(1, 1), b3 + hstepB, voffB); PG8_STAGE(PG8_SA(1, 0), a3, voffA);
            PG8_WAIT_V(8); PG8_WAIT_L(0); PG8_BAR; PG8_MMA(1, 0, At, B0); PG8_MMA(1, 1, At, B1); PG8_BAR; PG8_SCHED;
            }
        }
        if (wr == 0) PG8_BAR;
        E(acc, cur, wr, wc, fr, fq, lds, wid, lane);
        if (!has_next) break;
        cur = nxt; cA = nA; cB = nB; ++ui;
        if (wr == 1) PG8_BAR;
    }
    PG8_WAIT_V(0);
    PG8_BAR;
#undef PG8_SA
#undef PG8_SB
#undef PG8_STAGE
#undef PG8_LDA
#undef PG8_LDB
#undef PG8_MMA
#undef PG8_WAIT_V
#undef PG8_WAIT_L
#undef PG8_BAR
#undef PG8_SCHED
#undef PG8_APTR
#undef PG8_BPTR
}
}

__device__ __forceinline__ void tr_item(const float* W, int ldw, const float* ksc, bf16_t* WT, int K, int k0, int n0_dst, int n0_src, LAS float* scr, int lane) {
    float wv[32];
#pragma unroll
    for (int i = 0; i < 32; ++i) { const int kk = 2 * i + (lane >> 5); wv[i] = W[(size_t)(k0 + kk) * ldw + n0_src + (lane & 31)]; }
#pragma unroll
    for (int i = 0; i < 32; ++i) { const int kk = 2 * i + (lane >> 5); const float s = ksc ? ksc[k0 + kk] : 1.0f; scr[kk * 33 + (lane & 31)] = wv[i] * s; }
    asm volatile("s_waitcnt lgkmcnt(0)" ::: "memory");
    const int c = lane & 7;
#pragma unroll
    for (int j = 0; j < 4; ++j) { const int n = (lane >> 3) + 8 * j; const LAS float* s = scr + (8 * c) * 33 + n;
        u32x4 o; o.x = pk2(s[0 * 33], s[1 * 33]); o.y = pk2(s[2 * 33], s[3 * 33]); o.z = pk2(s[4 * 33], s[5 * 33]); o.w = pk2(s[6 * 33], s[7 * 33]);
        *(u32x4*)(WT + (size_t)(n0_dst + n) * K + k0 + 8 * c) = o; }
    asm volatile("s_waitcnt lgkmcnt(0)" ::: "memory");
}
__device__ __forceinline__ void tr_weight(const float* W, int ldw, const float* ksc, bf16_t* WT, int K, int N, int gu, int item, LAS float* scr, int lane) {
    const int nblk = N / 32, kb = item / nblk, nb = item % nblk, n0 = 32 * nb;
    int n0s = n0;
    if (gu) { const int blk = n0 >> 7, pn = blk >> 1, bj = blk & 1; n0s = bj * DFF + pn * 128 + (n0 & 127); }
    tr_item(W, ldw, ksc, WT, K, 64 * kb, n0, n0s, scr, lane);
}
__device__ __forceinline__ void row2_to_bf16_ss(const float* x0, const float* x1, bf16_t* o0, bf16_t* o1, float* ss0, float* ss1, int lane) {
    const f32x4* xa = (const f32x4*)x0 + lane; const f32x4* xb = (const f32x4*)x1 + lane; f32x4 va[4], vb[4]; float sa = 0.f, sb = 0.f;
#pragma unroll
    for (int j = 0; j < 4; ++j) { va[j] = xa[64 * j]; vb[j] = xb[64 * j]; }
#pragma unroll
    for (int j = 0; j < 4; ++j) { sa += (va[j].x * va[j].x + va[j].y * va[j].y) + (va[j].z * va[j].z + va[j].w * va[j].w); sb += (vb[j].x * vb[j].x + vb[j].y * vb[j].y) + (vb[j].z * vb[j].z + vb[j].w * vb[j].w); }
    sa = wave_sum(sa); sb = wave_sum(sb);
    if (lane == 0) { *ss0 = sa; *ss1 = sb; }
    unsigned long long* pa = (unsigned long long*)o0 + lane; unsigned long long* pb = (unsigned long long*)o1 + lane;
#pragma unroll
    for (int j = 0; j < 4; ++j) { pa[64 * j] = (unsigned long long)pk2(va[j].x, va[j].y) | ((unsigned long long)pk2(va[j].z, va[j].w) << 32);
                                  pb[64 * j] = (unsigned long long)pk2(vb[j].x, vb[j].y) | ((unsigned long long)pk2(vb[j].z, vb[j].w) << 32); }
}
__device__ __forceinline__ void row_to_bf16_rstd(const float* xrow, bf16_t* orow, float* rstd_out, int lane) {
    const f32x4* xr = (const f32x4*)xrow + lane; f32x4 v[4]; float s = 0.f;
#pragma unroll
    for (int j = 0; j < 4; ++j) { v[j] = xr[64 * j]; s += (v[j].x * v[j].x + v[j].y * v[j].y) + (v[j].z * v[j].z + v[j].w * v[j].w); }
    s = wave_sum(s);
    if (lane == 0) *rstd_out = s;
    unsigned long long* o8 = (unsigned long long*)orow + lane;
#pragma unroll
    for (int j = 0; j < 4; ++j) o8[64 * j] = (unsigned long long)pk2(v[j].x, v[j].y) | ((unsigned long long)pk2(v[j].z, v[j].w) << 32);
}

#define LDS_BAR() do { asm volatile("s_waitcnt lgkmcnt(0)" ::: "memory"); __builtin_amdgcn_s_barrier(); asm volatile("" ::: "memory"); } while (0)
#define MFMA32(a, b, c) __builtin_amdgcn_mfma_f32_32x32x16_bf16((a), (b), (c), 0, 0, 0)
constexpr int KS_PITCH = 272, VT_PITCH = 520, VT_OFF = 256 * KS_PITCH  , MX_OFF = VT_OFF + 128 * VT_PITCH  , OS_PITCH = 272;
static_assert(MX_OFF + 2048 <= MISC_OFF, "attention LDS");
__device__ __forceinline__ void attn_unit(LAS unsigned char* lds, const bf16_t* Q, size_t qstride, const bf16_t* Kp, const bf16_t* Vp, size_t kstride,
                                          int kvalid0, int dilmode, float c_scale, float c_alibi, float* stats, size_t sstride, int tid) {
    const int lane = tid & 63, wave = __builtin_amdgcn_readfirstlane(tid >> 6), qt = wave & 3, kh = wave >> 2, r = lane & 31, h = lane >> 5;
    LAS unsigned char* Ks = lds; LAS unsigned char* Vt = lds + VT_OFF; LAS float* MX = (LAS float*)(lds + MX_OFF); LAS float* SM = MX + 256;
    u32x4 kv[8]; u32x4 vv[2][4]; bf16x8 qf[8];
    {
        const int t1 = wave * 64 + fresh_lane();
#pragma unroll
        for (int i = 0; i < 8; ++i) { const int c = t1 + 512 * i, row = c >> 4, cc = c & 15;
            kv[i] = (u32x4){0u, 0u, 0u, 0u};
            if (kvalid0 || i >= 4) kv[i] = *(const u32x4*)(Kp + (ptrdiff_t)row * (ptrdiff_t)kstride + cc * 8); }
#pragma unroll
        for (int i = 0; i < 2; ++i) { const int w = wave + 8 * i, kg = (w & 7) * 8 + (lane & 7), dg = (w >> 3) * 8 + (lane >> 3);
#pragma unroll
            for (int j = 0; j < 4; ++j) { vv[i][j] = (u32x4){0u, 0u, 0u, 0u};
                if (kvalid0 || (w & 7) >= 4) vv[i][j] = *(const u32x4*)(Vp + (ptrdiff_t)(4 * kg + j) * (ptrdiff_t)kstride + dg * 8); } }
#pragma unroll
        for (int s = 0; s < 8; ++s) qf[s] = *(const bf16x8*)(Q + (size_t)(qt * 32 + r) * qstride + 16 * s + 8 * h);
#pragma unroll
        for (int i = 0; i < 8; ++i) { const int c = t1 + 512 * i, row = c >> 4, cc = c & 15; *(LAS u32x4*)(Ks + row * KS_PITCH + cc * 16) = kv[i]; }
#pragma unroll
        for (int i = 0; i < 2; ++i) { const int w = wave + 8 * i, kg = (w & 7) * 8 + (lane & 7), dg = (w >> 3) * 8 + (lane >> 3);
#pragma unroll
            for (int q = 0; q < 4; ++q) { const unsigned a = vv[i][0][q], b = vv[i][1][q], c = vv[i][2][q], d = vv[i][3][q];
                u32x2 e, o; e.x = (a & 0xffffu) | (b << 16); e.y = (c & 0xffffu) | (d << 16); o.x = (a >> 16) | (b & 0xffff0000u); o.y = (c >> 16) | (d & 0xffff0000u);
                *(LAS u32x2*)(Vt + (dg * 8 + 2 * q) * VT_PITCH + kg * 8) = e; *(LAS u32x2*)(Vt + (dg * 8 + 2 * q + 1) * VT_PITCH + kg * 8) = o; } }
    }
    LDS_BAR();
    const int NS = dilmode ? 3 : 4;
    int tb[4]; bool tv[4];
    {
        const int P = kvalid0 ? 4 - qt : 0, L = P + qt + 1, n0 = (L + 1) >> 1, e0 = kh == 0 ? 0 : n0, e1 = kh == 0 ? n0 : L;
#pragma unroll
        for (int j = 0; j < 4; ++j) {
            if (dilmode) { const int e = e0 + j; tv[j] = e < e1; const int ee = tv[j] ? e : 0; tb[j] = ee < P ? (qt + ee) * 32 : 128 + (ee - P) * 32; }
            else { tv[j] = true; tb[j] = (kh * 4 + j) * 32; }
        }
    }
    f32x16 acc[4];
    const int qi = qt * 32 + r; float mloc = -1e30f;
#pragma unroll
    for (int j = 0; j < 4; ++j)
#pragma unroll
        for (int i = 0; i < 16; ++i) acc[j][i] = 0.f;
#pragma unroll
    for (int s = 0; s < 8; ++s)
#pragma unroll
        for (int j = 0; j < 4; ++j)
            if (j < NS) { const bf16x8 a = *(const LAS bf16x8*)(Ks + (tb[j] + r) * KS_PITCH + (16 * s + 8 * h) * 2); acc[j] = MFMA32(a, qf[s], acc[j]); }
#pragma unroll
    for (int j = 0; j < 4; ++j)
        if (j < NS) {
#pragma unroll
            for (int i = 0; i < 16; ++i) {
                float sv = acc[j][i] * c_scale;
                if (dilmode) {
                    const int delta = 128 + qi - (tb[j] + (i & 3) + 8 * (i >> 2) + 4 * h);
                    sv = (tv[j] && (unsigned)delta <= 128u) ? sv - c_alibi * (float)delta : -1e30f;
                }
                acc[j][i] = sv; mloc = fmaxf(mloc, sv);
            }
        }
    mloc = fmaxf(mloc, shfl_xor_f(mloc, 32));
    if (h == 0) MX[kh * 128 + qi] = mloc;
    LDS_BAR();
    const float mfin = fmaxf(MX[qi], MX[128 + qi]);
    float ssum = 0.f;
#pragma unroll
    for (int j = 0; j < 4; ++j)
        if (j < NS) {
#pragma unroll
            for (int i = 0; i < 16; ++i) { const float p = __builtin_amdgcn_exp2f(acc[j][i] - mfin); acc[j][i] = p; ssum += p; }
        }
    ssum += shfl_xor_f(ssum, 32);
    if (h == 0) SM[kh * 128 + qi] = ssum;
    f32x16 o[4];
#pragma unroll
    for (int dt = 0; dt < 4; ++dt)
#pragma unroll
        for (int i = 0; i < 16; ++i) o[dt][i] = 0.f;
#pragma unroll
    for (int j = 0; j < 4; ++j)
        if (j < NS) {
#pragma unroll
            for (int s = 0; s < 2; ++s) {
                u32x4 pp; pp.x = pk2(acc[j][8 * s + 0], acc[j][8 * s + 1]); pp.y = pk2(acc[j][8 * s + 2], acc[j][8 * s + 3]); pp.z = pk2(acc[j][8 * s + 4], acc[j][8 * s + 5]); pp.w = pk2(acc[j][8 * s + 6], acc[j][8 * s + 7]);
                const bf16x8 pa = __builtin_bit_cast(bf16x8, pp);
#pragma unroll
                for (int dt = 0; dt < 4; ++dt) {
                    const LAS unsigned char* vp = Vt + (dt * 32 + r) * VT_PITCH + (tb[j] + 16 * s + 4 * h) * 2;
                    const u32x2 lo = *(const LAS u32x2*)vp, hi = *(const LAS u32x2*)(vp + 16);
                    const u32x4 bb = (u32x4){lo.x, lo.y, hi.x, hi.y};
                    o[dt] = MFMA32(pa, __builtin_bit_cast(bf16x8, bb), o[dt]);
                }
            }
        }
    LAS float* EX = (LAS float*)Ks;
    const int lane_l = fresh_lane();
#define ATT_TAIL(M0, M1, X0, X1) do { \
        _Pragma("unroll") for (int i = 0; i < 16; ++i) { EX[((wave * 2 + 0) * 16 + i) * 64 + lane_l] = o[X0][i]; EX[((wave * 2 + 1) * 16 + i) * 64 + lane_l] = o[X1][i]; } \
        LDS_BAR();                                         \
        { const int r = lane_l & 31, h = lane_l >> 5, pw_ = (wave ^ 4); \
          _Pragma("unroll") for (int i = 0; i < 16; ++i) { \
            const int qrow = qt * 32 + (i & 3) + 8 * (i >> 2) + 4 * h; \
            const float l = SM[qrow] + SM[128 + qrow]; const float inv = __builtin_amdgcn_rcpf(l); \
            const float v0 = (o[M0][i] + EX[((pw_ * 2 + 0) * 16 + i) * 64 + lane_l]) * inv, v1 = (o[M1][i] + EX[((pw_ * 2 + 1) * 16 + i) * 64 + lane_l]) * inv; \
            bf16_t* orow_ = (bf16_t*)Q + (size_t)qrow * qstride + r; orow_[(M0) * 32] = (bf16_t)f2bf(v0); orow_[(M1) * 32] = (bf16_t)f2bf(v1);     \
            if (kh == 0 && stats != nullptr && r == 0) { float* sp = stats + (size_t)qrow * sstride; sp[0] = fmaxf(MX[qrow], MX[128 + qrow]); sp[1] = l; } \
          } } } while (0)
    if (kh == 0) ATT_TAIL(0, 1, 2, 3); else ATT_TAIL(2, 3, 0, 1);
#undef ATT_TAIL
    LDS_BAR();
}

__device__ __forceinline__ int hg_permpos(int col) { const int w = col & 15; return (col & ~15) + 8 * ((w >> 2) & 1) + 4 * (w >> 3) + (w & 3); }
struct HgRaw { unsigned fr[16], qr[16], vr[16]; };
__device__ __forceinline__ void hgA_load(HgRaw& w, const bf16_t* P, int h, int tid) {
    const int col = tid & 127, tg = tid >> 7;
#pragma unroll
    for (int j = 0; j < 16; ++j) { const bf16_t* pr = P + (size_t)(tg * 16 + j) * PITCH + h * 128 + col; w.qr[j] = pr[C_HQ]; w.vr[j] = pr[C_HI]; }
#pragma unroll
    for (int j = 0; j < 16; ++j) { const bf16_t* pr = P + (size_t)(tg * 16 + j) * PITCH + h * 128 + col; w.fr[j] = pr[C_HF]; }
}
__device__ __forceinline__ void hgA_unit(LAS unsigned char* lds, const HgRaw& w, bf16_t* P, int h, const float* lb_logits, bf16_t* KT, bf16_t* VTg, bf16_t* SC, float* DD, int tid) {
    LAS float* TOT = (LAS float*)lds; LAS unsigned char* QT = lds + 2048; LAS unsigned char* KL = lds + 2048 + 64 * 272;
    const int col = tid & 127, tg = tid >> 7, lane = tid & 63, wave = __builtin_amdgcn_readfirstlane(tid >> 6);
    const float a0 = lb_logits[h * 128 + col], a1 = lb_logits[512 + h * 128 + col]; const float lb = 1.0f / (1.0f + __expf(a1 - a0));
    const unsigned (&fr)[16] = w.fr; const unsigned (&qr)[16] = w.qr; const unsigned (&vr)[16] = w.vr;
    float f[16], p[16]; float run = 0.f;
#pragma unroll
    for (int j = 0; j < 16; ++j) { f[j] = lb + (1.0f - lb) * sigmoidf_(bflo(fr[j])); run += __logf(f[j]); p[j] = run; }
    TOT[tg * 128 + col] = run;
    LDS_BAR();
    const float t0 = TOT[col], t1 = TOT[128 + col], t2 = TOT[256 + col], t3 = TOT[384 + col];
    const float off = (tg > 0 ? t0 : 0.f) + (tg > 1 ? t1 : 0.f) + (tg > 2 ? t2 : 0.f), ref = t0 + t1, blast = (t0 + t1) + (t2 + t3);
    const int pcol = hg_permpos(col);
    unsigned kp[8];
#pragma unroll
    for (int j = 0; j < 16; ++j) {
        const int row = tg * 16 + j; const float b = off + p[j], qv = bflo(qr[j]), q = qv * sigmoidf_(qv), k = 1.0f - f[j];
        *(LAS bf16_t*)(QT + row * 272 + col * 2) = (bf16_t)f2bf(q * __expf(b - ref));
        *(LAS bf16_t*)(KL + row * 272 + col * 2) = (bf16_t)f2bf(k * __expf(ref - b));
        P[(size_t)row * PITCH + C_HQ + h * 128 + pcol] = (bf16_t)f2bf(q * __expf(b));
        const unsigned kb = f2bf(k * __expf(blast - b));
        if (j & 1) kp[j >> 1] |= kb << 16; else kp[j >> 1] = kb;
    }
    { u32x4* kd = (u32x4*)(KT + col * 64 + tg * 16); kd[0] = (u32x4){kp[0], kp[1], kp[2], kp[3]}; kd[1] = (u32x4){kp[4], kp[5], kp[6], kp[7]};
      unsigned vp[8];
#pragma unroll
      for (int j = 0; j < 8; ++j) vp[j] = vr[2 * j] | (vr[2 * j + 1] << 16);
      u32x4* vd = (u32x4*)(VTg + col * 64 + tg * 16); vd[0] = (u32x4){vp[0], vp[1], vp[2], vp[3]}; vd[1] = (u32x4){vp[4], vp[5], vp[6], vp[7]};
      if (tg == 0) DD[col] = __expf(blast); }
    LDS_BAR();
    if (wave < 4) {
        const int ctile = wave >> 1, stile = wave & 1, r = lane & 31, hh = lane >> 5;
        f32x16 acc;
#pragma unroll
        for (int i = 0; i < 16; ++i) acc[i] = 0.f;
#pragma unroll
        for (int ks = 0; ks < 8; ++ks) {
            const bf16x8 av = *(const LAS bf16x8*)(QT + (ctile * 32 + r) * 272 + (16 * ks + 8 * hh) * 2);
            const bf16x8 bv = *(const LAS bf16x8*)(KL + (stile * 32 + r) * 272 + (16 * ks + 8 * hh) * 2);
            acc = MFMA32(av, bv, acc);
        }
        const int sabs = stile * 32 + r;
#pragma unroll
        for (int i = 0; i < 16; ++i) { const int cabs = ctile * 32 + (i & 3) + 8 * (i >> 2) + 4 * hh; SC[cabs * 64 + sabs] = (bf16_t)f2bf(sabs <= cabs ? acc[i] : 0.f); }
    }
    LDS_BAR();
}
constexpr int HB_QP = 0, HB_KT = 64 * 272, HB_VT = HB_KT + 128 * 144, HB_SC = HB_VT + 128 * 144, HB_D = HB_SC + 64 * 144, HB_BUF = HB_D + 512;
static_assert(2 * HB_BUF <= MISC_OFF, "hgB LDS");
__device__ __forceinline__ void hgB_unit(LAS unsigned char* lds, bf16_t* Pb, int h, const bf16_t* KT, const bf16_t* VTg, const bf16_t* SC, const float* DD, int tid) {
    const int lane = tid & 63, wave = __builtin_amdgcn_readfirstlane(tid >> 6), dvt = wave & 3, ct = wave >> 2, r = lane & 31, hh = lane >> 5;
    f32x16 S[4];
#pragma unroll
    for (int t = 0; t < 4; ++t)
#pragma unroll
        for (int i = 0; i < 16; ++i) S[t][i] = 0.f;
    u32x4 pq[2], pk[2], pv[2], ps, pd;
#define HB_LOAD(n) do { \
        _Pragma("unroll") for (int i_ = 0; i_ < 2; ++i_) { const int idx = tid + 512 * i_; \
            pq[i_] = *(const u32x4*)(Pb + (size_t)((n) * 64 + (idx >> 4)) * PITCH + C_HQ + h * 128 + (idx & 15) * 8); \
            pk[i_] = *(const u32x4*)(KT + (size_t)(n) * 4 * 8192 + idx * 8); pv[i_] = *(const u32x4*)(VTg + (size_t)(n) * 4 * 8192 + idx * 8); } \
        ps = *(const u32x4*)(SC + (size_t)(n) * 4 * 4096 + tid * 8); \
        if (tid < 32) pd = *(const u32x4*)(DD + (size_t)(n) * 4 * 128 + tid * 4); } while (0)
#define HB_WRITE(buf) do { LAS unsigned char* B_ = lds + (buf) * HB_BUF; \
        _Pragma("unroll") for (int i_ = 0; i_ < 2; ++i_) { const int idx = tid + 512 * i_; \
            *(LAS u32x4*)(B_ + HB_QP + (idx >> 4) * 272 + (idx & 15) * 16) = pq[i_]; \
            *(LAS u32x4*)(B_ + HB_KT + (idx >> 3) * 144 + (idx & 7) * 16) = pk[i_]; *(LAS u32x4*)(B_ + HB_VT + (idx >> 3) * 144 + (idx & 7) * 16) = pv[i_]; } \
        *(LAS u32x4*)(B_ + HB_SC + (tid >> 3) * 144 + (tid & 7) * 16) = ps; \
        if (tid < 32) *(LAS u32x4*)(B_ + HB_D + tid * 16) = pd; } while (0)
    HB_LOAD(0); HB_WRITE(0);
    LDS_BAR();
#ifndef HB_REP
#define HB_REP 1
#endif
    for (int nn = 0; nn < 64 * HB_REP; ++nn) {
        const int n = nn & 63;
        if (HB_REP > 1 && n == 0) {
#pragma unroll
            for (int t = 0; t < 4; ++t)
#pragma unroll
                for (int i = 0; i < 16; ++i) S[t][i] = 0.f;
        }
        if (nn + 1 < 64 * HB_REP) HB_LOAD((nn + 1) & 63);
        const LAS unsigned char* B = lds + (n & 1) * HB_BUF;
        bf16x8 vb[4];
#pragma unroll
        for (int ks = 0; ks < 4; ++ks) vb[ks] = *(const LAS bf16x8*)(B + HB_VT + (dvt * 32 + r) * 144 + (16 * ks + 8 * hh) * 2);
        f32x16 O, O2;
#pragma unroll
        for (int i = 0; i < 16; ++i) { O[i] = 0.f; O2[i] = 0.f; }
#pragma unroll
        for (int ks = 0; ks < 4; ++ks) { const bf16x8 av = *(const LAS bf16x8*)(B + HB_SC + (ct * 32 + r) * 144 + (16 * ks + 8 * hh) * 2); O2 = MFMA32(av, vb[ks], O2); }
#pragma unroll
        for (int t = 0; t < 4; ++t)
#pragma unroll
            for (int s2 = 0; s2 < 2; ++s2) {
                u32x4 xp; xp.x = pk2(S[t][8 * s2 + 0], S[t][8 * s2 + 1]); xp.y = pk2(S[t][8 * s2 + 2], S[t][8 * s2 + 3]); xp.z = pk2(S[t][8 * s2 + 4], S[t][8 * s2 + 5]); xp.w = pk2(S[t][8 * s2 + 6], S[t][8 * s2 + 7]);
                const bf16x8 av = *(const LAS bf16x8*)(B + HB_QP + (ct * 32 + r) * 272 + (32 * t + 16 * s2 + 8 * hh) * 2);
                if (t & 1) O2 = MFMA32(av, __builtin_bit_cast(bf16x8, xp), O2); else O = MFMA32(av, __builtin_bit_cast(bf16x8, xp), O);
            }
#pragma unroll
        for (int i = 0; i < 16; ++i) O[i] += O2[i];
#pragma unroll
        for (int t = 0; t < 4; ++t) {
#pragma unroll
            for (int a4 = 0; a4 < 4; ++a4) { const f32x4 dd = *(const LAS f32x4*)(B + HB_D + (32 * t + 8 * a4 + 4 * hh) * 4);
#pragma unroll
                for (int b = 0; b < 4; ++b) S[t][4 * a4 + b] *= dd[b]; }
#pragma unroll
            for (int ks = 0; ks < 4; ++ks) { const bf16x8 av = *(const LAS bf16x8*)(B + HB_KT + (32 * t + r) * 144 + (16 * ks + 8 * hh) * 2); S[t] = MFMA32(av, vb[ks], S[t]); }
        }
        if (nn + 1 < 64 * HB_REP) HB_WRITE((n + 1) & 1);
#pragma unroll
        for (int i = 0; i < 16; ++i) Pb[(size_t)(n * 64 + ct * 32 + (i & 3) + 8 * (i >> 2) + 4 * hh) * PITCH + C_HI + h * 128 + dvt * 32 + r] = (bf16_t)f2bf(O[i]);
        LDS_BAR();
    }
#undef HB_LOAD
#undef HB_WRITE
}


#define XB_TMO      128
#define XB_XCNT(j)  (256  + 64 * (j))
#define XB_XSUB(j)  (1280 + 64 * (j))
#define XB_XGEN(j)  (2304 + 64 * (j))
#define XB_TOP      3328
#define XB_TOPGEN   3392
#define XCD_BAR_WORDS 3456
#define XB_SPIN_CAP (1u << 18)
__device__ __forceinline__ unsigned xb_ld(unsigned* p)              { return __hip_atomic_load(p, __ATOMIC_RELAXED, __HIP_MEMORY_SCOPE_AGENT); }
__device__ __forceinline__ unsigned xb_add(unsigned* p, unsigned v) { return __hip_atomic_fetch_add(p, v, __ATOMIC_RELAXED, __HIP_MEMORY_SCOPE_AGENT); }
__device__ __forceinline__ unsigned xb_xcc_id() { return (unsigned)__builtin_amdgcn_s_getreg((3 << 11) | 20) & 0xFu; }
#define XB_SPIN(cond, bar) do { unsigned _sp = 0; while (cond) { __builtin_amdgcn_s_sleep(1); \
    if ((++_sp & 255u) == 0u) { if (xb_ld(&(bar)[XB_TMO])) break; if (_sp > XB_SPIN_CAP) { atomicAdd(&(bar)[XB_TMO], 1u); break; } } } } while (0)
__device__ __forceinline__ void xcd_barrier_complete(unsigned* bar, unsigned x, unsigned& nloc, unsigned& nx) {
    const unsigned G = gridDim.x * gridDim.y * gridDim.z;
    unsigned sum, cnt, mine, sp = 0u;
    for (;;) {
        sum = 0u; cnt = 0u; mine = 0u;
#pragma unroll
        for (unsigned j = 0; j < 16; ++j) { const unsigned c = xb_ld(&bar[XB_XCNT(j)]); sum += c; cnt += (c > 0u) ? 1u : 0u; mine = (j == x) ? c : mine; }
        if (sum == G) break;
        __builtin_amdgcn_s_sleep(1);
        if ((++sp & 255u) == 0u) { if (xb_ld(&bar[XB_TMO])) break; if (sp > XB_SPIN_CAP) { atomicAdd(&bar[XB_TMO], 1u); break; } }
    }
    nloc = mine > 0u ? mine : 1u; nx = cnt > 0u ? cnt : 1u;
}
__device__ __forceinline__ void xcd_barrier(unsigned* bar, volatile LAS unsigned* st, const bool t0) {
    asm volatile("s_waitcnt vmcnt(0)" ::: "memory");
    __syncthreads();
    if (t0) {
        const unsigned x = xb_xcc_id();
        __builtin_amdgcn_s_waitcnt(0);
        unsigned nloc = st[0], nx = st[1];
        if (nloc == 0u) { xcd_barrier_complete(bar, x, nloc, nx); st[0] = nloc; st[1] = nx; }
        const unsigned old = xb_add(&bar[XB_XSUB(x)], 1u);
        const unsigned gen = old / nloc;
        if (old + 1u == (gen + 1u) * nloc) {
            __builtin_amdgcn_fence(__ATOMIC_RELEASE, "agent");
            asm volatile("s_waitcnt vmcnt(0)" ::: "memory");
            const unsigned og = xb_add(&bar[XB_TOP], 1u);
            const unsigned tg = og / nx;
            if (og + 1u == (tg + 1u) * nx) xb_add(&bar[XB_TOPGEN], 1u);
            else XB_SPIN(xb_ld(&bar[XB_TOPGEN]) == tg, bar);
            __builtin_amdgcn_fence(__ATOMIC_ACQUIRE, "agent");
            xb_add(&bar[XB_XGEN(x)], 1u);
            asm volatile("s_waitcnt vmcnt(0)" ::: "memory");
        } else {
            XB_SPIN(xb_ld(&bar[XB_XGEN(x)]) == gen, bar);
            __builtin_amdgcn_fence(__ATOMIC_ACQUIRE, "agent");
            asm volatile("s_waitcnt vmcnt(0)" ::: "memory");
        }
    }
    __syncthreads();
}

struct Args { const float* in[22]; float* out; unsigned char* ws; int ph_lo, ph_hi; };

__global__ void __launch_bounds__(512, 2) mega(Args a) {
    extern __shared__ __attribute__((aligned(16))) unsigned char lds_raw[];
    LAS unsigned char* lds = (LAS unsigned char*)lds_raw;
    volatile LAS unsigned* MISC = (volatile LAS unsigned*)(lds + MISC_OFF);
    cg::grid_group grid = cg::this_grid();
    const int wave0 = __builtin_amdgcn_readfirstlane((int)threadIdx.x >> 6);
    if (threadIdx.x < 16) MISC[threadIdx.x] = 0u;
    __syncthreads();
    if (threadIdx.x == 0) (void)xb_add(&((unsigned*)(a.ws + WS_XBAR))[XB_XCNT(xb_xcc_id())], 1u);
    if (threadIdx.x == 0) {
        const float** tb = (const float**)(a.ws + WS_TBL);
        tb[0] = a.in[0]; tb[1] = a.in[1]; tb[2] = a.in[2]; tb[3] = a.in[3]; tb[4] = a.in[4]; tb[5] = a.in[5]; tb[6] = a.in[6]; tb[7] = a.in[7]; tb[8] = a.in[8]; tb[9] = a.in[9]; tb[10] = a.in[10];
        tb[11] = a.in[11]; tb[12] = a.in[12]; tb[13] = a.in[13]; tb[14] = a.in[14]; tb[15] = a.in[15]; tb[16] = a.in[16]; tb[17] = a.in[17]; tb[18] = a.in[18]; tb[19] = a.in[19]; tb[20] = a.in[20]; tb[21] = a.in[21];
        tb[22] = (const float*)a.out;
        __builtin_amdgcn_fence(__ATOMIC_RELEASE, "agent");
    }
    __syncthreads();
    __builtin_amdgcn_fence(__ATOMIC_ACQUIRE, "agent");
    for (int ph = a.ph_lo; ph < a.ph_hi; ++ph) {
#define TIDLANE const int tid = wave * 64 + fresh_lane(); const int lane = tid & 63; (void)lane; (void)tid
        __attribute__((address_space(1))) unsigned char* wsg = (__attribute__((address_space(1))) unsigned char*)a.ws; asm volatile("" : "+s"(wsg));
        unsigned char* ws = (unsigned char*)wsg;
        const float* const* tbl = (const float* const*)(ws + WS_TBL);
        float* out = (float*)uptr(tbl[22]);
        int wave = wave0; asm volatile("" : "+s"(wave));
        const int G = gridDim.x, bx = blockIdx.x;
        const int gw = bx * 8 + wave, NGW = G * 8;
        bf16_t* const AB = (bf16_t*)(ws + WS_AB);
        bf16_t* const R = (bf16_t*)(ws + WS_R);
        float* const STATS = (float*)(ws + WS_STATS);
        bf16_t* const MKV = (bf16_t*)(ws + WS_MKV);
        int kind, half = 0;
        if (ph < 3) kind = ph; else if (ph < 15) { const int sl = (ph - 3) % 6; half = (ph - 3) / 6; kind = sl == 0 ? 4 : (sl == 1 ? 13 : 3 + sl); } else kind = ph == 15 ? 10 : 11;
        bf16_t* const PROJ = R;
        const size_t hrow0 = (size_t)half * TH;
        if (kind == 0) {
            TIDLANE;
            LAS float* scr = (LAS float*)(lds + wave * 16384);
            constexpr int I_GU = 16 * 176, I_D = 44 * 32, I_IN = 16 * 320, I_SQ = 16 * 32, I_BR = 8 * 32;
            constexpr int NITEMS = 2 * I_GU + 2 * I_D + I_IN + 2 * I_SQ + 3 * I_BR;
            for (int it = gw; it < NITEMS; it += NGW) {
                int r = it;
                if (r < I_GU) { tr_weight(uptr(tbl[3]), 2 * DFF, uptr(tbl[2]), (bf16_t*)(ws + WS_WGU1), D, 2 * DFF, 1, r, scr, lane); continue; } r -= I_GU;
                if (r < I_GU) { tr_weight(uptr(tbl[19]), 2 * DFF, uptr(tbl[18]), (bf16_t*)(ws + WS_WGU2), D, 2 * DFF, 1, r, scr, lane); continue; } r -= I_GU;
                if (r < I_D) { tr_weight(uptr(tbl[4]), D, nullptr, (bf16_t*)(ws + WS_WD1), DFF, D, 0, r, scr, lane); continue; } r -= I_D;
                if (r < I_D) { tr_weight(uptr(tbl[20]), D, nullptr, (bf16_t*)(ws + WS_WD2), DFF, D, 0, r, scr, lane); continue; } r -= I_D;
                if (r < I_IN) { tr_weight(uptr(tbl[7]), DIN, uptr(tbl[6]), (bf16_t*)(ws + WS_WIN), D, DIN, 0, r, scr, lane); continue; } r -= I_IN;
                if (r < I_SQ) { tr_weight(uptr(tbl[12]), D, uptr(tbl[11]), (bf16_t*)(ws + WS_WMKV), D, D, 0, r, scr, lane); continue; } r -= I_SQ;
                if (r < I_SQ) { tr_weight(uptr(tbl[16]), D, nullptr, (bf16_t*)(ws + WS_WOUT), D, D, 0, r, scr, lane); continue; } r -= I_SQ;
                if (r < I_BR) { tr_weight(uptr(tbl[13]), D, nullptr, (bf16_t*)(ws + WS_WBR), 512, D, 0, r, scr, lane); continue; } r -= I_BR;
                if (r < I_BR) { tr_weight(uptr(tbl[14]), D, nullptr, (bf16_t*)(ws + WS_WBR + 1 * MiB), 512, D, 0, r, scr, lane); continue; } r -= I_BR;
                tr_weight(uptr(tbl[15]), D, nullptr, (bf16_t*)(ws + WS_WBR + 2 * MiB), 512, D, 0, r, scr, lane);
            }
            { const float* xin = uptr(tbl[0]);
            for (int m = gw; m < T; m += 2 * NGW) {
                const int m2 = m + NGW;
                row2_to_bf16_ss(xin + (size_t)m * D, xin + (size_t)m2 * D, AB + (size_t)m * D, AB + (size_t)m2 * D, (float*)(ws + WS_SS1) + m, (float*)(ws + WS_SS1) + m2, lane);
                if (lane < 2) { ((float*)(ws + WS_SS2))[lane * T + m] = 0.f; ((float*)(ws + WS_SS2))[lane * T + m2] = 0.f; }
                if (lane == 2) { if (m < 3 * 256 * 16) ((unsigned*)(ws + WS_CNT))[m] = 0u; if (m2 < 3 * 256 * 16) ((unsigned*)(ws + WS_CNT))[m2] = 0u; } } }
            for (int m = gw; m < NMEMROWS; m += NGW) row_to_bf16_rstd(uptr(tbl[1]) + (size_t)m * D, (bf16_t*)(ws + WS_MEMB) + (size_t)m * D, (float*)(ws + WS_RSTDM) + m, lane);
            if (bx == 0 && tid < 64) ((unsigned*)(ws + WS_CTR))[tid] = 0u;
        } else if (kind == 1 || kind == 10) {
            TIDLANE;
            pg8::Gemm g{AB, AB, AB, (const bf16_t*)(ws + (kind == 1 ? WS_WGU1 : WS_WGU2)), nullptr, nullptr, D, D, D};
            pg8::OrderT<1> S; S.init(T, 2 * DFF, G, bx);
            pg8::EpiSwiGLU E{R, (const float*)(ws + (kind == 1 ? WS_SS1 : WS_SS3))};
            pg8::gemm_phase<pg8::EpiSwiGLU, 1>(lds, g, S, E, wave);
        } else if (kind == 2 || kind == 11 || kind == 8) {
            TIDLANE;
            pg8::Gemm g; pg8::OrderT<1> S; pg8::EpiNormRes E;
            if (kind == 8) {
                g = pg8::Gemm{PROJ + C_YM, nullptr, nullptr, (const bf16_t*)(ws + WS_WOUT), nullptr, nullptr, PITCH, D, D};
                S.init(TH, D, G, bx);
                E = pg8::EpiNormRes{out, out, uptr(tbl[17]), ws, 1, (int)hrow0, half * 128};
            } else {
                g = pg8::Gemm{R, nullptr, nullptr, (const bf16_t*)(ws + (kind == 2 ? WS_WD1 : WS_WD2)), nullptr, nullptr, DFF, DFF, DFF};
                S.init(T, D, G, bx);
                if (kind == 2) E = pg8::EpiNormRes{uptr(tbl[0]), out, uptr(tbl[5]), ws, 0, 0, 0};
                else E = pg8::EpiNormRes{out, out, uptr(tbl[21]), ws, 2, 0, 0};
            }
            pg8::gemm_phase<pg8::EpiNormRes, 1>(lds, g, S, E, wave);
        } else if (kind == 4) {
            TIDLANE;
            for (int job = (half == 0 ? 0 : 1); job < 2; ++job) {
                pg8::Gemm g; pg8::OrderT<1> S; pg8::EpiProj E;
                if (job == 0) {
                    g = pg8::Gemm{(const bf16_t*)(ws + WS_MEMB), nullptr, nullptr, (const bf16_t*)(ws + WS_WMKV), nullptr, nullptr, D, D, D};
                    S.init(NMEMROWS, D, G, bx); E = pg8::EpiProj{MKV, D, (const float*)(ws + WS_RSTDM), uptr(tbl[8]), 1 << 20};
                } else {
                    g = pg8::Gemm{AB + hrow0 * D, nullptr, nullptr, (const bf16_t*)(ws + WS_WIN), nullptr, nullptr, D, D, D};
                    S.init(TH, DIN, G, bx); E = pg8::EpiProj{PROJ, PITCH, (const float*)(ws + WS_SS2) + hrow0, uptr(tbl[8]), C_GATE / 256};
                }
                pg8::gemm_phase<pg8::EpiProj, 1>(lds, g, S, E, wave);
            }
        } else if (kind == 5) {
            TIDLANE;
            unsigned* ctr = (unsigned*)(ws + WS_CTR) + half;
            constexpr int NHG = 32, NDIL = 3072, NMEMU = 1024, NTOT = NHG + NDIL + NMEMU;
            const float c_scale = 0.08838834764831845f * 1.4426950408889634f;
            if (tid == 0) MISC[0] = __hip_atomic_fetch_add(ctr, 1u, __ATOMIC_RELAXED, __HIP_MEMORY_SCOPE_AGENT);
            LDS_BAR();
            for (;;) {
                const int idx = (int)MISC[0];
                LDS_BAR();
                if (idx >= NTOT) break;
                unsigned nxt_idx = 0u;
                if (tid == 0) nxt_idx = __hip_atomic_fetch_add(ctr, 1u, __ATOMIC_RELAXED, __HIP_MEMORY_SCOPE_AGENT);
                if (idx < NHG) {
                    const int b = idx >> 2, hh = idx & 3; const size_t ch0 = (size_t)(b * 64) * 4 + hh;
                    hgB_unit(lds, PROJ + (size_t)b * SEQ * PITCH, hh, (const bf16_t*)(ws + WS_HGKT) + ch0 * 8192, (const bf16_t*)(ws + WS_HGVT) + ch0 * 8192,
                             (const bf16_t*)(ws + WS_HGSC) + ch0 * 4096, (const float*)(ws + WS_HGD) + ch0 * 128, tid);
                } else if (idx < NHG + NDIL) {
                    const int u = idx - NHG, b = u / 384, rem = u % 384, gi = rem >> 7, rem2 = rem & 127, hh = rem2 & 3, blk = rem2 >> 2;
                    const int dil = gi == 0 ? 1 : (gi == 1 ? 4 : 16), nb = 32 / dil, n = blk % nb, rr = blk / nb;
                    const ptrdiff_t tok0 = (ptrdiff_t)b * SEQ + (ptrdiff_t)n * 128 * dil + rr;
                    const bf16_t* q = PROJ + tok0 * PITCH + C_DIL + gi * 1536 + hh * 128;
                    const bf16_t* kp = PROJ + (tok0 - 128 * dil) * PITCH + C_DIL + gi * 1536 + 512 + hh * 128;
                    const float slope = exp2f(-8.0f * (float)(gi * 4 + hh + 1) / 12.0f);
                    attn_unit(lds, q, (size_t)dil * PITCH, kp, kp + 512, (size_t)dil * PITCH, n > 0 ? 1 : 0, 1, c_scale, slope * (float)dil * 1.4426950408889634f,
                              STATS + ((size_t)tok0 * 12 + gi * 4 + hh) * 2, (size_t)dil * 24, tid);
                } else {
                    const int u = idx - NHG - NDIL, b = u >> 7, rem = u & 127, hh = rem & 3, qb = rem >> 2;
                    const bf16_t* q = PROJ + ((size_t)b * SEQ + qb * 128) * PITCH + C_MQ + hh * 128;
                    const bf16_t* kp = MKV + (size_t)((half * 8 + b) * 256) * D + hh * 128;
                    attn_unit(lds, q, (size_t)PITCH, kp, kp + 512, (size_t)D, 1, 0, c_scale, 0.f, nullptr, 0, tid);
                }
                if (tid == 0) MISC[0] = nxt_idx;
                LDS_BAR();
            }
        } else if (kind == 13) {
            TIDLANE;
            HgRaw cur, nxt;
#pragma unroll
            for (int j = 0; j < 16; ++j) { cur.fr[j] = 0u; cur.qr[j] = 0u; cur.vr[j] = 0u; nxt.fr[j] = 0u; nxt.qr[j] = 0u; nxt.vr[j] = 0u; }
            if (bx < 2048) hgA_load(cur, PROJ + (size_t)(bx >> 2) * 64 * PITCH, bx & 3, tid);
            for (int u = bx; u < 2048; u += G) {
                const int hh = u & 3, bn = u >> 2, un = u + G;
                if (un < 2048) hgA_load(nxt, PROJ + (size_t)(un >> 2) * 64 * PITCH, un & 3, tid);
                hgA_unit(lds, cur, PROJ + (size_t)bn * 64 * PITCH, hh, uptr(tbl[9]), (bf16_t*)(ws + WS_HGKT) + (size_t)u * 8192, (bf16_t*)(ws + WS_HGVT) + (size_t)u * 8192,
                         (bf16_t*)(ws + WS_HGSC) + (size_t)u * 4096, (float*)(ws + WS_HGD) + (size_t)u * 128, tid);
                cur = nxt;
            }
        } else if (kind == 6) {
            TIDLANE;
            const float* hgw = uptr(tbl[10]);
            float wv[8];
#pragma unroll
            for (int j = 0; j < 8; ++j) wv[j] = hgw[(lane & 15) * 8 + j];
            const int hh = lane >> 4;
            for (int r0 = gw; r0 < TH; r0 += 2 * NGW) {
                bf16_t* prow[2]; u32x4 ow[2], gwd[2], d0[2], d1[2], d2[2]; float sm[2][6];
#pragma unroll
                for (int e = 0; e < 2; ++e) {
                    const int r = r0 + e * NGW; prow[e] = PROJ + (size_t)r * PITCH;
                    ow[e] = *(const u32x4*)(prow[e] + C_HI + lane * 8); gwd[e] = *(const u32x4*)(prow[e] + C_HOG + lane * 8);
                    d0[e] = *(const u32x4*)(prow[e] + C_DIL + lane * 8); d1[e] = *(const u32x4*)(prow[e] + C_DIL + 1536 + lane * 8); d2[e] = *(const u32x4*)(prow[e] + C_DIL + 3072 + lane * 8);
                    const float* st = STATS + ((size_t)r * 12 + hh) * 2;
                    sm[e][0] = st[0]; sm[e][1] = st[1]; sm[e][2] = st[8]; sm[e][3] = st[9]; sm[e][4] = st[16]; sm[e][5] = st[17];
                }
#pragma unroll
                for (int e = 0; e < 2; ++e) {
                    float o8[8] = {bflo(ow[e].x), bfhi(ow[e].x), bflo(ow[e].y), bfhi(ow[e].y), bflo(ow[e].z), bfhi(ow[e].z), bflo(ow[e].w), bfhi(ow[e].w)};
                    const float g8[8] = {bflo(gwd[e].x), bfhi(gwd[e].x), bflo(gwd[e].y), bfhi(gwd[e].y), bflo(gwd[e].z), bfhi(gwd[e].z), bflo(gwd[e].w), bfhi(gwd[e].w)};
                    float sq = 0.f;
#pragma unroll
                    for (int j = 0; j < 8; ++j) sq += o8[j] * o8[j];
                    sq += shfl_xor_f(sq, 1); sq += shfl_xor_f(sq, 2); sq += shfl_xor_f(sq, 4); sq += shfl_xor_f(sq, 8);
                    const float rs = __builtin_amdgcn_rsqf(sq * (1.0f / 128.0f) + EPS);
#pragma unroll
                    for (int j = 0; j < 8; ++j) o8[j] = o8[j] * rs * wv[j] * sigmoidf_(g8[j]);
                    u32x4 yw; yw.x = pk2(o8[0], o8[1]); yw.y = pk2(o8[2], o8[3]); yw.z = pk2(o8[4], o8[5]); yw.w = pk2(o8[6], o8[7]);
                    *(u32x4*)(prow[e] + C_HI + lane * 8) = yw;
                    const float m0 = sm[e][0], l0 = sm[e][1], m1 = sm[e][2], l1 = sm[e][3], m2 = sm[e][4], l2 = sm[e][5];
                    const float mm = fmaxf(m0, fmaxf(m1, m2));
                    float w0 = __builtin_amdgcn_exp2f(m0 - mm) * l0, w1 = __builtin_amdgcn_exp2f(m1 - mm) * l1, w2 = __builtin_amdgcn_exp2f(m2 - mm) * l2;
                    const float inv = __builtin_amdgcn_rcpf(w0 + w1 + w2); w0 *= inv; w1 *= inv; w2 *= inv;
                    const u32x4 a0 = d0[e], a1 = d1[e], a2 = d2[e];
                    u32x4 dw;
                    dw.x = pk2(w0 * bflo(a0.x) + w1 * bflo(a1.x) + w2 * bflo(a2.x), w0 * bfhi(a0.x) + w1 * bfhi(a1.x) + w2 * bfhi(a2.x));
                    dw.y = pk2(w0 * bflo(a0.y) + w1 * bflo(a1.y) + w2 * bflo(a2.y), w0 * bfhi(a0.y) + w1 * bfhi(a1.y) + w2 * bfhi(a2.y));
                    dw.z = pk2(w0 * bflo(a0.z) + w1 * bflo(a1.z) + w2 * bflo(a2.z), w0 * bfhi(a0.z) + w1 * bfhi(a1.z) + w2 * bfhi(a2.z));
                    dw.w = pk2(w0 * bflo(a0.w) + w1 * bflo(a1.w) + w2 * bflo(a2.w), w0 * bfhi(a0.w) + w1 * bfhi(a1.w) + w2 * bfhi(a2.w));
                    *(u32x4*)(prow[e] + C_DIL + lane * 8) = dw;
                }
            }
        } else if (kind == 7) {
            TIDLANE;
            pg8::Gemm g{PROJ + C_HI, PROJ + C_DIL, PROJ + C_MQ, (const bf16_t*)(ws + WS_WBR), (const bf16_t*)(ws + WS_WBR + 1 * MiB), (const bf16_t*)(ws + WS_WBR + 2 * MiB), PITCH, 512, 512};
            pg8::OrderT<3> S; S.init(TH, D, G, bx);
            pg8::EpiMerge E{PROJ + C_GATE, PITCH, PROJ + C_YM, PITCH};
            pg8::gemm_phase<pg8::EpiMerge, 3>(lds, g, S, E, wave);
        }
        if (ph + 1 < a.ph_hi) {
            if (a.ph_hi > NPH) grid.sync();
            else xcd_barrier((unsigned*)(ws + WS_XBAR), MISC + 8, wave == 0 && fresh_lane() == 0);
        }
    }
}

extern "C" void kernel_launch(void* const* d_in, const int* in_sizes, int n_in, void* d_out, int out_size, void* d_ws, size_t ws_size, hipStream_t stream) {
    static int grid = 0;
    if (grid == 0) {
        if (n_in != 22 || out_size != T * D || ws_size < WS_END) { fprintf(stderr, "kernel_launch: unexpected shapes (n_in %d out %d ws %zu)\n", n_in, out_size, ws_size); grid = -1; return; }
        int dev = 0, cus = 0, per_cu = 0;
        hipGetDevice(&dev); hipDeviceGetAttribute(&cus, hipDeviceAttributeMultiprocessorCount, dev);
        hipFuncSetAttribute((const void*)mega, hipFuncAttributeMaxDynamicSharedMemorySize, LDS_BYTES);
        hipOccupancyMaxActiveBlocksPerMultiprocessor(&per_cu, (const void*)mega, 512, LDS_BYTES);
        if (per_cu < 1) { fprintf(stderr, "kernel_launch: occupancy query says %d blocks/CU\n", per_cu); per_cu = 1; }
        grid = cus * per_cu;
        while (grid > 1 && ((TH % (16 * grid)) != 0)) --grid;
        (void)hipGetLastError();
    }
    if (grid < 0) return;
    (void)hipMemsetAsync((char*)d_ws + WS_XBAR, 0, 16384, stream);
    Args a{};
    for (int i = 0; i < 22; ++i) a.in[i] = (const float*)d_in[i];
    a.out = (float*)d_out; a.ws = (unsigned char*)d_ws;
#if MK_MULTI
    for (int ph = 0; ph < NPH; ++ph) { a.ph_lo = ph; a.ph_hi = ph + 1; hipLaunchKernelGGL(mega, dim3(grid), dim3(512), LDS_BYTES, stream, a); }
#else
    a.ph_lo = 0; a.ph_hi = NPH;
    void* args[] = {&a};
    hipError_t e = hipLaunchCooperativeKernel((const void*)mega, dim3(grid), dim3(512), args, LDS_BYTES, stream);
    if (e != hipSuccess) fprintf(stderr, "cooperative launch failed: %s (grid %d)\n", hipGetErrorString(e), grid);
#endif
}
```
